# Optimizing an MI355X kernel written in HIP

```python
import jax, jax.numpy as jnp
from jax import lax
import numpy as np

D_MODEL = 1024
BATCH = 8
SEQ = 2048
DEPTH = 2

GRID_W = 64
CTX_LEN = 256
EPS = 1e-6

HEAD_DIM = 64
N_HEADS = D_MODEL // (2 * HEAD_DIM)
N_KV_HEADS = max(1, N_HEADS // 4)
Q_PER_KV = N_HEADS // N_KV_HEADS
ATTN_W = N_HEADS * HEAD_DIM
KV_W = N_KV_HEADS * HEAD_DIM
Q_BLOCK = 128
ROPE_THETA = 10000.0
ROPE_PAIRS_PER_AXIS = HEAD_DIM // 4
ATTN_SCALE = HEAD_DIM ** -0.5

CHUNK = 128
SGU_W = D_MODEL // 4
SGU_GROUPS = 4
SGU_GROUP_W = SGU_W // SGU_GROUPS

POOL_WINDOWS = (2, 4, 8, 16)
POOL_W = D_MODEL // 4
POOL_GROUPS = len(POOL_WINDOWS)
POOL_GROUP_W = POOL_W // POOL_GROUPS

MIX_W = ATTN_W + SGU_W + POOL_W
O_Q = 0
O_K = O_Q + ATTN_W
O_V = O_K + KV_W
O_G = O_V + KV_W
O_P = O_G + 2 * SGU_W
IN_W = O_P + POOL_W

D_FF = -(-8 * D_MODEL // (3 * 256)) * 256

kernel_name = "hybrid_parallel_attn_sgu_pool_dit"


def rms_norm(x, g):
    xf = x.astype(jnp.float32)
    y = xf * lax.rsqrt(jnp.mean(xf * xf, axis=-1, keepdims=True) + EPS)
    return (y * g.astype(jnp.float32)).astype(x.dtype)


def modulate(x, g, shift, scale):
    return rms_norm(x, g) * (1 + scale[:, None, :]) + shift[:, None, :]


def axial_rope(n_tokens):
    rows_count = n_tokens // GRID_W
    rows = jnp.repeat(jnp.arange(rows_count, dtype=jnp.float32), GRID_W)
    cols = jnp.tile(jnp.arange(GRID_W, dtype=jnp.float32), rows_count)
    inv = ROPE_THETA ** (-jnp.arange(ROPE_PAIRS_PER_AXIS, dtype=jnp.float32) / ROPE_PAIRS_PER_AXIS)
    ang = jnp.concatenate([rows[:, None] * inv, cols[:, None] * inv], axis=-1)
    return jnp.cos(ang), jnp.sin(ang)


def apply_rope(x, cos, sin):
    xf = x.astype(jnp.float32)
    x1, x2 = xf[..., : HEAD_DIM // 2], xf[..., HEAD_DIM // 2:]
    c = cos[None, :, None, :]
    s = sin[None, :, None, :]
    return jnp.concatenate([x1 * c - x2 * s, x2 * c + x1 * s], axis=-1).astype(x.dtype)


def q_heads(zq, q_norm):
    B, N = zq.shape[:2]
    return rms_norm(zq.reshape(B, N, N_HEADS, HEAD_DIM), q_norm)


def kv_heads(zk, zv, k_norm):
    B, N = zk.shape[:2]
    k = rms_norm(zk.reshape(B, N, N_KV_HEADS, HEAD_DIM), k_norm)
    v = zv.reshape(B, N, N_KV_HEADS, HEAD_DIM)
    return k, v


def latent_attention(q, k, v, k_ctx, v_ctx):
    B, S = q.shape[:2]
    L = k_ctx.shape[1]
    nb = S // Q_BLOCK
    qb = q.reshape(B, nb, Q_BLOCK, N_KV_HEADS, Q_PER_KV, HEAD_DIM).transpose(1, 0, 2, 3, 4, 5)

    def one_block(qblk):
        s_ctx = jnp.einsum('bqkgd,bskd->bkgqs', qblk, k_ctx).astype(jnp.float32)
        s_lat = jnp.einsum('bqkgd,bskd->bkgqs', qblk, k).astype(jnp.float32)
        s = jnp.concatenate([s_ctx, s_lat], axis=-1) * ATTN_SCALE
        p = jax.nn.softmax(s, axis=-1).astype(v.dtype)
        return (jnp.einsum('bkgqs,bskd->bqkgd', p[..., :L], v_ctx)
                + jnp.einsum('bkgqs,bskd->bqkgd', p[..., L:], v))

    o = lax.map(one_block, qb)
    return o.transpose(1, 0, 2, 3, 4, 5).reshape(B, S, ATTN_W)


def context_attention(q, k, v):
    B, L = q.shape[:2]
    qg = q.reshape(B, L, N_KV_HEADS, Q_PER_KV, HEAD_DIM)
    s = jnp.einsum('bqkgd,bskd->bkgqs', qg, k).astype(jnp.float32) * ATTN_SCALE
    p = jax.nn.softmax(s, axis=-1).astype(v.dtype)
    return jnp.einsum('bkgqs,bskd->bqkgd', p, v).reshape(B, L, ATTN_W)


def spatial_gating(zg, sgu_norm, w_s, b_s):
    B, N = zg.shape[:2]
    z = jax.nn.gelu(zg)
    u, v = z[..., :SGU_W], z[..., SGU_W:]
    v = rms_norm(v, sgu_norm).reshape(B, N // CHUNK, CHUNK, SGU_GROUPS, SGU_GROUP_W)
    mixed = jnp.einsum('hpq,bnqhc->bnphc', w_s, v) + b_s.T[:, :, None]
    return u * mixed.reshape(B, N, SGU_W)


def multiscale_pool(p, pool_w, pool_scale):
    B, N = p.shape[:2]
    pf = p.reshape(B, N, POOL_GROUPS, POOL_GROUP_W).astype(jnp.float32)
    cs = jnp.concatenate([jnp.zeros((B, 1, POOL_GROUPS, POOL_GROUP_W), jnp.float32),
                          jnp.cumsum(pf, axis=1)], axis=1)
    t = jnp.arange(N)
    means = []
    for g, w in enumerate(POOL_WINDOWS):
        lo = jnp.clip(t - w // 2, 0, N)
        hi = jnp.clip(t - w // 2 + w, 0, N)
        win_sum = cs[:, hi, g] - cs[:, lo, g]
        means.append(win_sum / (hi - lo).astype(jnp.float32)[None, :, None])
    d = (jnp.stack(means, axis=2) - pf).astype(p.dtype)
    out = jnp.einsum('bngc,gcd->bngd', d, pool_w).reshape(B, N, POOL_W)
    return out * pool_scale


def swiglu(h, w_gate, w_up, w_down):
    return (jax.nn.silu(h @ w_gate) * (h @ w_up)) @ w_down


def setup_inputs(seed: int = 0) -> dict:
    key = jax.random.key(seed)
    ks = jax.random.split(key, 24)
    f32 = jnp.float32

    def nrm(k, shape, s):
        return jax.random.normal(k, shape, f32) * s

    return {
        "x": nrm(ks[0], (BATCH, SEQ, D_MODEL), 1.0),
        "c": nrm(ks[1], (BATCH, D_MODEL), 1.0),
        "ctx": nrm(ks[2], (BATCH, CTX_LEN, D_MODEL), 1.0),
        "c_ctx": nrm(ks[3], (D_MODEL,), 1.0),
        "w_mod": nrm(ks[4], (DEPTH, D_MODEL, 6 * D_MODEL), 0.5 * D_MODEL ** -0.5),
        "b_mod": nrm(ks[5], (DEPTH, 6 * D_MODEL), 0.02),
        "norm1": 1.0 + nrm(ks[6], (DEPTH, D_MODEL), 0.02),
        "norm2": 1.0 + nrm(ks[7], (DEPTH, D_MODEL), 0.02),
        "w_in": nrm(ks[8], (DEPTH, D_MODEL, IN_W), D_MODEL ** -0.5),
        "q_norm": 1.0 + nrm(ks[9], (DEPTH, HEAD_DIM), 0.02),
        "k_norm": 1.0 + nrm(ks[10], (DEPTH, HEAD_DIM), 0.02),
        "sgu_norm": 1.0 + nrm(ks[11], (DEPTH, SGU_W), 0.02),
        "w_s": nrm(ks[12], (DEPTH, SGU_GROUPS, CHUNK, CHUNK), CHUNK ** -0.5),
        "b_s": 1.0 + nrm(ks[13], (DEPTH, SGU_GROUPS, CHUNK), 0.02),
        "pool_w": nrm(ks[14], (DEPTH, POOL_GROUPS, POOL_GROUP_W, POOL_GROUP_W), POOL_GROUP_W ** -0.5),
        "pool_scale": 1.0 + nrm(ks[15], (DEPTH, POOL_W), 0.02),
        "w_out": nrm(ks[16], (DEPTH, MIX_W, D_MODEL), MIX_W ** -0.5),
        "w_gate": nrm(ks[17], (DEPTH, D_MODEL, D_FF), D_MODEL ** -0.5),
        "w_up": nrm(ks[18], (DEPTH, D_MODEL, D_FF), D_MODEL ** -0.5),
        "w_down": nrm(ks[19], (DEPTH, D_FF, D_MODEL), D_FF ** -0.5),
        "final_norm": 1.0 + nrm(ks[20], (D_MODEL,), 0.02),
    }


def reference(x, c, ctx, c_ctx, w_mod, b_mod, norm1, norm2, w_in, q_norm, k_norm,
              sgu_norm, w_s, b_s, pool_w, pool_scale, w_out, w_gate, w_up, w_down,
              final_norm):
    cos, sin = axial_rope(x.shape[1])
    for l in range(DEPTH):
        last = l == DEPTH - 1
        mod = jax.nn.silu(c) @ w_mod[l] + b_mod[l]
        mod_c = jax.nn.silu(c_ctx)[None, :] @ w_mod[l] + b_mod[l]
        sh1, sc1, gt1, sh2, sc2, gt2 = jnp.split(mod, 6, axis=-1)
        csh1, csc1, cgt1, csh2, csc2, cgt2 = jnp.split(mod_c, 6, axis=-1)

        h = modulate(x, norm1[l], sh1, sc1)
        hc = modulate(ctx, norm1[l], csh1, csc1)
        z = h @ w_in[l]
        q = apply_rope(q_heads(z[..., O_Q:O_K], q_norm[l]), cos, sin)
        k, v = kv_heads(z[..., O_K:O_V], z[..., O_V:O_G], k_norm[l])
        k = apply_rope(k, cos, sin)

        if last:
            zc_kv = hc @ w_in[l][:, O_K:O_G]
            k_c, v_c = kv_heads(zc_kv[..., :KV_W], zc_kv[..., KV_W:], k_norm[l])
        else:
            zc = hc @ w_in[l]
            k_c, v_c = kv_heads(zc[..., O_K:O_V], zc[..., O_V:O_G], k_norm[l])

        attn = latent_attention(q, k, v, k_c, v_c)
        sgu = spatial_gating(z[..., O_G:O_P], sgu_norm[l], w_s[l], b_s[l])
        pool = multiscale_pool(z[..., O_P:], pool_w[l], pool_scale[l])
        mix = jnp.concatenate([attn, sgu, pool], axis=-1) @ w_out[l]

        if not last:
            q_c = q_heads(zc[..., O_Q:O_K], q_norm[l])
            attn_c = context_attention(q_c, k_c, v_c)
            sgu_c = spatial_gating(zc[..., O_G:O_P], sgu_norm[l], w_s[l], b_s[l])
            pool_c = multiscale_pool(zc[..., O_P:], pool_w[l], pool_scale[l])
            mix_c = jnp.concatenate([attn_c, sgu_c, pool_c], axis=-1) @ w_out[l]
            ctx = ctx + cgt1[:, None, :] * mix_c
            hc2 = modulate(ctx, norm2[l], csh2, csc2)
            ctx = ctx + cgt2[:, None, :] * swiglu(hc2, w_gate[l], w_up[l], w_down[l])

        x = x + gt1[:, None, :] * mix
        h2 = modulate(x, norm2[l], sh2, sc2)
        x = x + gt2[:, None, :] * swiglu(h2, w_gate[l], w_up[l], w_down[l])

    return rms_norm(x, final_norm)
```

```cpp
#include <hip/hip_runtime.h>
#include <hip/hip_bf16.h>
#include <cstdio>
#include <cstdint>
#include <cmath>
namespace pg8 {
#define PG8_LAS __attribute__((address_space(3)))
typedef unsigned short bf16_t;
typedef short bf16x8 __attribute__((ext_vector_type(8)));
typedef float f32x4 __attribute__((ext_vector_type(4)));
typedef unsigned u32x4 __attribute__((ext_vector_type(4)));
constexpr int BM = 256, BK = 64, HALF = 128, HTB = HALF * BK * 2  , STAGE_BYTES = 8 * HTB, NXCD = 8, WGM = 8;

__host__ __device__ __forceinline__ int lds_byte(int r, int c) { const int st = (r >> 4) * 2 + (c >> 5), rr = r & 15, cc = c & 31, ob = rr * 64 + cc * 2; return st * 1024 + (ob ^ (((ob >> 9) & 1) << 5)); }
__host__ __device__ __forceinline__ void stage_rc(int b, int& R, int& C) { const int st = b / 1024, sb = b % 1024, swz = sb ^ (((sb >> 9) & 1) << 5); R = (st >> 1) * 16 + swz / 64; C = (st & 1) * 32 + (swz % 64) / 2; }
__host__ __device__ __forceinline__ int perm32(int rho) { const int n = rho >> 4, i = rho & 15; return 8 * (i >> 2) + 4 * n + (i & 3); }

struct Unit { int pm, pn, k0b, nt, slice; };
struct Gemm { const bf16_t* A; const bf16_t* Bt; int M, N, K; };

struct StaticOrder {
    static constexpr bool SPLIT = false;
    int nM, nN, nwg, G, c;
    __host__ __device__ void init(int M, int N, int G_, int c_) { nM = M / BM; nN = N / BM; nwg = nM * nN; G = G_; c = c_; }
    __host__ __device__ bool next(int i, Unit& u) const { const long L = (long)i * G + c; if (L >= nwg) return false; map((int)L, u); return true; }
    __host__ __device__ void map(int L, Unit& u) const {
        int wgid = L; { const int q = nwg / NXCD, r = nwg % NXCD, xcd = wgid % NXCD, off = wgid / NXCD; wgid = (xcd < r ? xcd * (q + 1) : r * (q + 1) + (xcd - r) * q) + off; }
        const int nig = WGM * nN, gid = wgid / nig, fm = gid * WGM, gsz = (nM - fm) < WGM ? (nM - fm) : WGM;
        u.pm = fm + ((wgid % nig) % gsz); u.pn = (wgid % nig) / gsz;
    }
    __device__ __forceinline__ void a_ready(const Unit&) const {}
    __device__ __forceinline__ void done(const Unit&) const {}
};

__device__ __forceinline__ unsigned cvt_pk_bf16(float lo, float hi) { unsigned r; asm volatile("v_cvt_pk_bf16_f32 %0, %1, %2" : "=v"(r) : "v"(lo), "v"(hi)); return r; }
typedef float f32x2 __attribute__((ext_vector_type(2)));
typedef unsigned u32x2 __attribute__((ext_vector_type(2)));
constexpr int XOFF = 132096;
struct EpiStoreBf16 {
    static constexpr bool PERM = true, AFTER_DRAIN = false, PREFETCH = true;
    bf16_t* O; int ldc; const float* rss; const float* bias; int ldb; PG8_LAS unsigned char* lds; float* rssv;
    __device__ __forceinline__ void prefetch(const Unit& u, int ui, int tid, int wid) const {
        const float* src = (wid < 4) ? rss + (size_t)u.pm * BM + tid : bias + (size_t)(u.pm < 64 ? (u.pm >> 3) : 8) * ldb + (size_t)u.pn * BM + (tid - 256);
        __builtin_amdgcn_global_load_lds((const unsigned*)src, (PG8_LAS unsigned*)(lds + XOFF + (ui & 1) * 2048 + wid * 256), 4, 0, 0);
    }
    static __device__ __forceinline__ float gelu1(float x) { const float y = 0.7978845608028654f * (x + 0.044715f * x * x * x); return x * __builtin_amdgcn_rcpf(1.0f + __builtin_amdgcn_exp2f(y * -2.8853900817779268f)); }
    __device__ __forceinline__ void operator()(const f32x4 (&acc)[2][2][4][2], const Unit& u, int wr, int wc, int fr, int fq, int ui) const {
        const int row0 = u.pm * BM + wr * 64 + fr, col0 = u.pn * BM + wc * 32 + 8 * fq;
        const bool act = (u.pn == 3) | (u.pn == 4);
        const PG8_LAS float* xs = (const PG8_LAS float*)(lds + XOFF + (ui & 1) * 2048);
        f32x4 bv[2][2];
#pragma unroll
        for (int bj = 0; bj < 2; ++bj)
#pragma unroll
            for (int n = 0; n < 2; ++n) bv[bj][n] = *(const PG8_LAS f32x4*)(xs + 256 + wc * 32 + 8 * fq + bj * HALF + 4 * n);
#pragma unroll
        for (int ai = 0; ai < 2; ++ai)
#pragma unroll
            for (int m = 0; m < 4; ++m) { const int rl = wr * 64 + fr + ai * HALF + m * 16; bf16_t* rowp = O + (size_t)(u.pm * BM + rl) * ldc + col0;
                const float rs = 1.0f / sqrtf(xs[rl] * (1.0f / 1024.0f) + 1e-6f);
                float rsq = 0.f;
#pragma unroll
                for (int bj = 0; bj < 2; ++bj) { f32x4 v0 = acc[ai][bj][m][0] * rs + bv[bj][0], v1 = acc[ai][bj][m][1] * rs + bv[bj][1];
                    if (act) {
#pragma unroll
                        for (int e = 0; e < 4; ++e) { v0[e] = gelu1(v0[e]); v1[e] = gelu1(v1[e]); }
                        rsq += ((v0[0] * v0[0] + v0[1] * v0[1]) + (v0[2] * v0[2] + v0[3] * v0[3])) + ((v1[0] * v1[0] + v1[1] * v1[1]) + (v1[2] * v1[2] + v1[3] * v1[3])); }
                    u32x4 w; w.x = cvt_pk_bf16(v0[0], v0[1]); w.y = cvt_pk_bf16(v0[2], v0[3]); w.z = cvt_pk_bf16(v1[0], v1[1]); w.w = cvt_pk_bf16(v1[2], v1[3]);
                    *(u32x4*)(rowp + bj * HALF) = w; }
                if (u.pn == 4) { rsq += __shfl_xor(rsq, 16); rsq += __shfl_xor(rsq, 32); if (fq == 0) atomicAdd(rssv + (u.pm * BM + rl), rsq); } }
    }
};
__device__ __forceinline__ float silu_mul(float g, float u) { const float e = __builtin_amdgcn_exp2f(g * -1.4426950408889634f); return g * __builtin_amdgcn_rcpf(1.0f + e) * u; }
struct EpiSwiGLU {
    static constexpr bool PERM = true, AFTER_DRAIN = false, PREFETCH = true;
    bf16_t* O; int ldc; const float* rss; const float* bias; int ldb; PG8_LAS unsigned char* lds;
    unsigned* ctx_done;
    __device__ __forceinline__ void prefetch(const Unit& u, int ui, int tid, int wid) const {
        const float* src = (wid < 4) ? rss + (size_t)u.pm * BM + tid : bias + (size_t)(u.pm < 64 ? (u.pm >> 3) : 8) * ldb + (size_t)u.pn * BM + (tid - 256);
        __builtin_amdgcn_global_load_lds((const unsigned*)src, (PG8_LAS unsigned*)(lds + XOFF + (ui & 1) * 2048 + wid * 256), 4, 0, 0);
    }
    __device__ __forceinline__ void operator()(const f32x4 (&acc)[2][2][4][2], const Unit& u, int wr, int wc, int fr, int fq, int ui) const {
        const int col0 = u.pn * HALF + wc * 32 + 8 * fq;
        const PG8_LAS float* xs = (const PG8_LAS float*)(lds + XOFF + (ui & 1) * 2048);
        const PG8_LAS float* bp = xs + 256 + wc * 32 + 8 * fq;
        const f32x4 bg0 = *(const PG8_LAS f32x4*)(bp), bg1 = *(const PG8_LAS f32x4*)(bp + 4), bu0 = *(const PG8_LAS f32x4*)(bp + HALF), bu1 = *(const PG8_LAS f32x4*)(bp + HALF + 4);
#pragma unroll
        for (int ai = 0; ai < 2; ++ai)
#pragma unroll
            for (int m = 0; m < 4; ++m) { const int rl = wr * 64 + fr + ai * HALF + m * 16; bf16_t* rowp = O + (size_t)(u.pm * BM + rl) * ldc + col0;
                const float rs = 1.0f / sqrtf(xs[rl] * (1.0f / 1024.0f) + 1e-6f);
                const f32x4 g0 = acc[ai][0][m][0] * rs + bg0, g1 = acc[ai][0][m][1] * rs + bg1, u0 = acc[ai][1][m][0] * rs + bu0, u1 = acc[ai][1][m][1] * rs + bu1;
                u32x4 w; w.x = cvt_pk_bf16(silu_mul(g0[0], u0[0]), silu_mul(g0[1], u0[1])); w.y = cvt_pk_bf16(silu_mul(g0[2], u0[2]), silu_mul(g0[3], u0[3]));
                w.z = cvt_pk_bf16(silu_mul(g1[0], u1[0]), silu_mul(g1[1], u1[1])); w.w = cvt_pk_bf16(silu_mul(g1[2], u1[2]), silu_mul(g1[3], u1[3]));
                *(u32x4*)rowp = w; }
        if (ctx_done != nullptr && u.pm >= 64) {
            asm volatile("s_waitcnt vmcnt(0)" ::: "memory"); __builtin_amdgcn_s_barrier(); asm volatile("" ::: "memory");
            if (threadIdx.x == 0) { __builtin_amdgcn_fence(__ATOMIC_RELEASE, "agent"); asm volatile("s_waitcnt vmcnt(0)" ::: "memory");
                __hip_atomic_fetch_add(ctx_done, 1u, __ATOMIC_RELAXED, __HIP_MEMORY_SCOPE_AGENT); } }
    }
};
struct CtxFirstOrder {
    static constexpr bool SPLIT = false;
    StaticOrder so;
    __host__ __device__ void init(int N, int G_, int c_) { so.init(16384, N, G_, c_); }
    __host__ __device__ int nctx() const { return 8 * so.nN; }
    __host__ __device__ bool next(int i, Unit& u) const {
        const long L = (long)i * so.G + so.c; const int nc = 8 * so.nN;
        if (L < nc) { u.pm = 64 + (int)(L & 7); u.pn = (int)(L >> 3); return true; }
        if (L - nc >= so.nwg) return false;
        so.map((int)(L - nc), u); return true;
    }
    __device__ __forceinline__ void a_ready(const Unit&) const {}
    __device__ __forceinline__ void done(const Unit&) const {}
};
struct SliceOrder {
    static constexpr bool SPLIT = true;
    int G, c, S, ntf;
    __host__ __device__ void init(int K, int S_, int G_, int c_) { G = G_; c = c_; S = S_; ntf = K / BK; }
    __host__ __device__ bool next(int i, Unit& u) const {
        const long L = (long)i * G + c; if (L >= 32 * S) return false;
        const int s = (int)L, tile = s / S, sl = s % S, P = ntf / 2, base = P / S, rem = P % S;
        u.pm = 64 + (tile & 7); u.pn = tile >> 3; u.nt = 2 * (base + (sl < rem ? 1 : 0)); u.k0b = (sl * base + (sl < rem ? sl : rem)) * 256; u.slice = s; return true;
    }
    __device__ __forceinline__ void a_ready(const Unit&) const {}
    __device__ __forceinline__ void done(const Unit&) const {}
};
struct EpiSlab {
    static constexpr bool PERM = true, AFTER_DRAIN = false, PREFETCH = false;
    float* slabs;
    __device__ __forceinline__ void operator()(const f32x4 (&acc)[2][2][4][2], const Unit& u, int wr, int wc, int fr, int fq) const {
        float* sp_ = slabs + (size_t)u.slice * 65536 + wc * 32 + 8 * fq + (size_t)(wr * 64 + fr) * 256;
#pragma unroll
        for (int ai = 0; ai < 2; ++ai)
#pragma unroll
            for (int m = 0; m < 4; ++m) { float* q = sp_ + (ai * HALF + m * 16) * 256;
                *(f32x4*)q = acc[ai][0][m][0]; *(f32x4*)(q + 4) = acc[ai][0][m][1]; *(f32x4*)(q + HALF) = acc[ai][1][m][0]; *(f32x4*)(q + HALF + 4) = acc[ai][1][m][1]; }
    }
};
typedef _Float16 f16x8 __attribute__((ext_vector_type(8)));
typedef float f32x8 __attribute__((ext_vector_type(8)));
__device__ __forceinline__ u32x4 pack_h8(const f32x4 a, const f32x4 b) { const f32x8 v = {a[0], a[1], a[2], a[3], b[0], b[1], b[2], b[3]}; return __builtin_bit_cast(u32x4, __builtin_convertvector(v, f16x8)); }
__device__ __forceinline__ void unpack_h8(const u32x4 w, f32x4& a, f32x4& b) { const f32x8 v = __builtin_convertvector(__builtin_bit_cast(f16x8, w), f32x8); a = (f32x4){v[0], v[1], v[2], v[3]}; b = (f32x4){v[4], v[5], v[6], v[7]}; }
template <bool BASEF32> struct EpiResid {
    static constexpr bool PERM = true, AFTER_DRAIN = false, PREFETCH = false;
    static constexpr int LDC = 1024, MODLD = 6144;
    const void* base; unsigned short* xh; const float* gate;
    const float* gn; const float* scn; bf16_t* H; float* rss;
    __device__ __forceinline__ void operator()(const f32x4 (&acc)[2][2][4][2], const Unit& u, int wr, int wc, int fr_in, int fq) const {
        int fr = fr_in; asm volatile("" : "+v"(fr));
        const int b = u.pm >> 3; const size_t t0 = (size_t)u.pm * BM * LDC;
        const float* bpf = (const float*)base + t0; const unsigned short* bph = (const unsigned short*)base + t0; unsigned short* op = xh + t0;
        const float* gp = gate + (size_t)b * MODLD; const float* sp = scn + (size_t)b * MODLD;
        const int col0 = u.pn * BM + wc * 32 + 8 * fq;
        float rsum[2][4];
#pragma unroll
        for (int ai = 0; ai < 2; ++ai)
#pragma unroll
            for (int m = 0; m < 4; ++m) rsum[ai][m] = 0.f;
#pragma unroll
        for (int bj = 0; bj < 2; ++bj) { const int cc = col0 + bj * HALF;
            const f32x4 gv0 = *(const f32x4*)(gp + cc), gv1 = *(const f32x4*)(gp + cc + 4);
            const f32x4 Gn0 = *(const f32x4*)(gn + cc) * (*(const f32x4*)(sp + cc) + 1.0f), Gn1 = *(const f32x4*)(gn + cc + 4) * (*(const f32x4*)(sp + cc + 4) + 1.0f);
#pragma unroll
            for (int am = 0; am < 4; ++am) { const int ai = am >> 1, mb = (am & 1) * 2; f32x4 b0[4], b1[4];
#pragma unroll
                for (int m = mb; m < mb + 2; ++m) { const size_t off = (size_t)(ai * HALF + wr * 64 + m * 16 + fr) * LDC + cc;
                    if constexpr (BASEF32) { b0[m] = *(const f32x4*)(bpf + off); b1[m] = *(const f32x4*)(bpf + off + 4); }
                    else { const u32x4 w = *(const u32x4*)(bph + off); unpack_h8(w, b0[m], b1[m]); } }
#pragma unroll
                for (int m = mb; m < mb + 2; ++m) { const int rl = ai * HALF + wr * 64 + m * 16 + fr; const size_t off = (size_t)rl * LDC + cc;
                    const f32x4 x0 = b0[m] + gv0 * acc[ai][bj][m][0], x1 = b1[m] + gv1 * acc[ai][bj][m][1]; *(u32x4*)(op + off) = pack_h8(x0, x1);
                    rsum[ai][m] += ((x0[0] * x0[0] + x0[1] * x0[1]) + (x0[2] * x0[2] + x0[3] * x0[3])) + ((x1[0] * x1[0] + x1[1] * x1[1]) + (x1[2] * x1[2] + x1[3] * x1[3]));
                    const f32x4 a0 = x0 * Gn0, a1 = x1 * Gn1;
                    u32x4 w; w.x = cvt_pk_bf16(a0[0], a0[1]); w.y = cvt_pk_bf16(a0[2], a0[3]); w.z = cvt_pk_bf16(a1[0], a1[1]); w.w = cvt_pk_bf16(a1[2], a1[3]);
                    *(u32x4*)(H + (size_t)(u.pm * BM + rl) * LDC + cc) = w; } } }
        {
#pragma unroll
            for (int ai = 0; ai < 2; ++ai)
#pragma unroll
                for (int m = 0; m < 4; ++m) { float sv = rsum[ai][m]; sv += __shfl_xor(sv, 16); sv += __shfl_xor(sv, 32);
                    if (fq == 0) atomicAdd(rss + (u.pm * BM + ai * HALF + wr * 64 + m * 16 + fr), sv); } }
    }
};

struct EpiResidFinal {
    static constexpr bool PERM = true, AFTER_DRAIN = false, PREFETCH = false;
    static constexpr int LDC = 1024, MODLD = 6144;
    const unsigned short* base; float* out; const float* gate; const float* fnorm; float* rss; unsigned* cnt; PG8_LAS unsigned* flag;
    __device__ __forceinline__ void operator()(f32x4 (&acc)[2][2][4][2], const Unit& u, int wr, int wc, int fr_in, int fq) const {
        int fr = fr_in; asm volatile("" : "+v"(fr));
        const int b = u.pm >> 3;
        const unsigned short* bp = base + (size_t)u.pm * BM * LDC; float* op = out + (size_t)u.pm * BM * LDC;
        const float* gp = gate + (size_t)b * MODLD;
        const int col0 = u.pn * BM + wc * 32 + 8 * fq;
        float rsum[2][4];
#pragma unroll
        for (int ai = 0; ai < 2; ++ai)
#pragma unroll
            for (int m = 0; m < 4; ++m) rsum[ai][m] = 0.f;
#pragma unroll
        for (int bj = 0; bj < 2; ++bj) { const int cc = col0 + bj * HALF;
            const f32x4 gv0 = *(const f32x4*)(gp + cc), gv1 = *(const f32x4*)(gp + cc + 4);
#pragma unroll
            for (int am = 0; am < 4; ++am) { const int ai = am >> 1, mb = (am & 1) * 2; f32x4 b0[4], b1[4];
#pragma unroll
                for (int m = mb; m < mb + 2; ++m) { const u32x4 w = *(const u32x4*)(bp + (size_t)(ai * HALF + wr * 64 + m * 16 + fr) * LDC + cc); unpack_h8(w, b0[m], b1[m]); }
#pragma unroll
                for (int m = mb; m < mb + 2; ++m) { const f32x4 x0 = b0[m] + gv0 * acc[ai][bj][m][0], x1 = b1[m] + gv1 * acc[ai][bj][m][1]; acc[ai][bj][m][0] = x0; acc[ai][bj][m][1] = x1;
                    rsum[ai][m] += ((x0[0] * x0[0] + x0[1] * x0[1]) + (x0[2] * x0[2] + x0[3] * x0[3])) + ((x1[0] * x1[0] + x1[1] * x1[1]) + (x1[2] * x1[2] + x1[3] * x1[3])); }
                asm volatile("" : "+v"(fr) : "v"(rsum[ai][mb + 1]) : "memory"); } }
#pragma unroll
        for (int ai = 0; ai < 2; ++ai)
#pragma unroll
            for (int m = 0; m < 4; ++m) { float sv = rsum[ai][m]; sv += __shfl_xor(sv, 16); sv += __shfl_xor(sv, 32);
                if (fq == 0) atomicAdd(rss + (u.pm * BM + ai * HALF + wr * 64 + m * 16 + fr), sv); }
        asm volatile("s_waitcnt vmcnt(0)" ::: "memory");
        __builtin_amdgcn_s_barrier(); asm volatile("" ::: "memory");
        if (threadIdx.x == 0) {
            __builtin_amdgcn_fence(__ATOMIC_RELEASE, "agent"); asm volatile("s_waitcnt vmcnt(0)" ::: "memory");
            __hip_atomic_fetch_add(cnt + 64 * u.pm, 1u, __ATOMIC_RELAXED, __HIP_MEMORY_SCOPE_AGENT);
            unsigned sp = 0;
            while (__hip_atomic_load(cnt + 64 * u.pm, __ATOMIC_RELAXED, __HIP_MEMORY_SCOPE_AGENT) < 4u) { __builtin_amdgcn_s_sleep(2); if (++sp > (1u << 20)) break; }
            __builtin_amdgcn_fence(__ATOMIC_ACQUIRE, "agent"); asm volatile("s_waitcnt vmcnt(0)" ::: "memory");
            flag[0] = 1u;
        }
        asm volatile("s_waitcnt vmcnt(0) lgkmcnt(0)" ::: "memory");
        __builtin_amdgcn_s_barrier(); asm volatile("" ::: "memory");
        asm volatile("" : "+v"(fr));
        float rs[2][4];
#pragma unroll
        for (int ai = 0; ai < 2; ++ai)
#pragma unroll
            for (int m = 0; m < 4; ++m) { float* q = rss + (u.pm * BM + ai * HALF + wr * 64 + m * 16 + fr); asm volatile("" : "+v"(q)); rs[ai][m] = 1.0f / sqrtf(__hip_atomic_load(q, __ATOMIC_RELAXED, __HIP_MEMORY_SCOPE_AGENT) * (1.0f / 1024.0f) + 1e-6f); }
#pragma unroll
        for (int bj = 0; bj < 2; ++bj) { const int cc = col0 + bj * HALF; const f32x4 f0 = *(const f32x4*)(fnorm + cc), f1 = *(const f32x4*)(fnorm + cc + 4);
#pragma unroll
            for (int ai = 0; ai < 2; ++ai)
#pragma unroll
                for (int m = 0; m < 4; ++m) { float* q = op + (size_t)(ai * HALF + wr * 64 + m * 16 + fr) * LDC + cc; asm volatile("" : "+v"(q));
                    *(f32x4*)q = acc[ai][bj][m][0] * rs[ai][m] * f0; *(f32x4*)(q + 4) = acc[ai][bj][m][1] * rs[ai][m] * f1; } }
    }
};
template <class Epi, class Sched, bool ALIGN_EPI = false, bool SP2 = false>
__device__ __forceinline__ void gemm_phase(PG8_LAS unsigned char* lds, const Gemm g, const Sched& S, const Epi& E) {
    int tid_ = threadIdx.x; asm volatile("" : "+v"(tid_));
    const int tid = tid_, wid = __builtin_amdgcn_readfirstlane(tid >> 6), lane = tid & 63, wr = wid >> 2, wc = wid & 3, fr = lane & 15, fq = lane >> 4;
    const int K = g.K, nt = K / BK;
    unsigned voffA[2], voffB[2];
#pragma unroll
    for (int i = 0; i < 2; ++i) { int R, C; stage_rc(tid * 16 + i * 8192, R, C); const int Rb = Epi::PERM ? ((R & ~31) + perm32(R & 31)) : R;
        voffA[i] = (unsigned)(R * K + C) * 2u; voffB[i] = (unsigned)(Rb * K + C) * 2u; }
    const size_t kstep = (size_t)(BK * 2);
    const size_t hstep = (size_t)HALF * K * 2;
    const size_t tstep = 2 * hstep;
    const unsigned ldsw = (unsigned)wid * 1024u;
    const int aoff = lds_byte(wr * 64 + fr, fq * 8), boff = lds_byte(wc * 32 + fr, fq * 8);
#define PG8_SA(b, h) (((b) * 2 + (h)) * HTB)
#define PG8_SB(b, h) ((4 + (b) * 2 + (h)) * HTB)
#define PG8_STAGE(bufoff, gbase, voff) do { _Pragma("unroll") for (int _i = 0; _i < 2; ++_i) \
        __builtin_amdgcn_global_load_lds((const unsigned*)((const char*)(gbase) + (voff)[_i]), (PG8_LAS unsigned*)(lds + (bufoff) + ldsw + _i * 8192), 16, 0, 0); } while (0)
#define PG8_LDA(dst, b, h) do { _Pragma("unroll") for (int m = 0; m < 4; ++m) _Pragma("unroll") for (int k = 0; k < 2; ++k) dst[m][k] = *(const PG8_LAS bf16x8*)(lds + PG8_SA(b, h) + aoff + m * 2048 + k * 1024); } while (0)
#define PG8_LDB(dst, b, h) do { _Pragma("unroll") for (int n = 0; n < 2; ++n) _Pragma("unroll") for (int k = 0; k < 2; ++k) dst[n][k] = *(const PG8_LAS bf16x8*)(lds + PG8_SB(b, h) + boff + n * 2048 + k * 1024); } while (0)
#define PG8_MMA(ai, bj, At, Bt) do { __builtin_amdgcn_s_setprio(1); _Pragma("unroll") for (int m = 0; m < 4; ++m) _Pragma("unroll") for (int n = 0; n < 2; ++n) _Pragma("unroll") for (int k = 0; k < 2; ++k) \
        acc[ai][bj][m][n] = __builtin_amdgcn_mfma_f32_16x16x32_bf16(Bt[n][k], At[m][k], acc[ai][bj][m][n], 0, 0, 0); __builtin_amdgcn_s_setprio(0); } while (0)
#define PG8_WAIT_V(n) asm volatile("s_waitcnt vmcnt(" #n ")" ::: "memory")
#define PG8_WAIT_L(n) asm volatile("s_waitcnt lgkmcnt(" #n ")" ::: "memory")
#define PG8_BAR __builtin_amdgcn_s_barrier()
#define PG8_SCHED __builtin_amdgcn_sched_barrier(0)
    Unit cur, nxt; int ui = 0;
    if (!S.next(0, cur)) return;
    if constexpr (!Sched::SPLIT) { cur.k0b = 0; cur.nt = nt; cur.slice = -1; }
    f32x4 acc[2][2][4][2];
#pragma unroll
    for (int a = 0; a < 2; ++a)
#pragma unroll
        for (int b = 0; b < 2; ++b)
#pragma unroll
            for (int m = 0; m < 4; ++m)
#pragma unroll
                for (int n = 0; n < 2; ++n) acc[a][b][m][n] = (f32x4){0.f, 0.f, 0.f, 0.f};
    bf16x8 At[4][2], B0[2][2], B1[2][2];
    const char* cA = (const char*)g.A + (size_t)cur.pm * tstep + cur.k0b; const char* cB = (const char*)g.Bt + (size_t)cur.pn * tstep + cur.k0b;
    S.a_ready(cur);
    if constexpr (SP2) {
        PG8_STAGE(PG8_SB(0, 0), cB, voffB); PG8_STAGE(PG8_SB(0, 1), cB + hstep, voffB); PG8_STAGE(PG8_SA(0, 0), cA, voffA); PG8_STAGE(PG8_SA(0, 1), cA + hstep, voffA);
        if (wr == 1) PG8_BAR;
        PG8_WAIT_V(2); PG8_BAR;
        PG8_STAGE(PG8_SB(1, 0), cB + kstep, voffB); PG8_STAGE(PG8_SA(1, 0), cA + kstep, voffA); PG8_STAGE(PG8_SB(1, 1), cB + hstep + kstep, voffB);
        PG8_WAIT_V(6); PG8_BAR;
    } else {
        PG8_STAGE(PG8_SB(0, 0), cB, voffB); PG8_STAGE(PG8_SA(0, 0), cA, voffA); PG8_STAGE(PG8_SB(0, 1), cB + hstep, voffB); PG8_STAGE(PG8_SA(0, 1), cA + hstep, voffA);
        if (wr == 1) PG8_BAR;
        PG8_WAIT_V(4); PG8_BAR;
        PG8_STAGE(PG8_SB(1, 0), cB + kstep, voffB); PG8_STAGE(PG8_SA(1, 0), cA + kstep, voffA); PG8_STAGE(PG8_SB(1, 1), cB + hstep + kstep, voffB);
        PG8_WAIT_V(6); PG8_BAR;
    }
    for (;;) {
        if constexpr (Epi::PREFETCH) E.prefetch(cur, ui, tid, wid);
        const bool has_next = S.next(ui + 1, nxt);
        if constexpr (!Sched::SPLIT) { nxt.k0b = 0; nxt.nt = nt; nxt.slice = -1; }
        const int unt = cur.nt;
        const char* nA = has_next ? (const char*)g.A + (size_t)nxt.pm * tstep + nxt.k0b : cA; const char* nB = has_next ? (const char*)g.Bt + (size_t)nxt.pn * tstep + nxt.k0b : cB;
        for (int t = 0; t < unt; t += 2) {
            const bool last = (t == unt - 2);
            const char* a1 = cA + (size_t)(t + 1) * kstep;
            const char* a2 = last ? nA : cA + (size_t)(t + 2) * kstep; const char* b2 = last ? nB : cB + (size_t)(t + 2) * kstep;
            const char* a3 = a2 + kstep; const char* b3 = b2 + kstep;
            if (last && has_next) S.a_ready(nxt);
            if constexpr (SP2) {
            PG8_LDB(B0, 0, 0); PG8_LDB(B1, 0, 1); PG8_SCHED; PG8_LDA(At, 0, 0); PG8_STAGE(PG8_SA(1, 1), a1 + hstep, voffA);
            PG8_WAIT_V(8); PG8_WAIT_L(0); PG8_BAR; PG8_MMA(0, 0, At, B0); PG8_MMA(0, 1, At, B1); PG8_BAR; PG8_SCHED;
            PG8_LDA(At, 0, 1); PG8_STAGE(PG8_SB(0, 0), b2, voffB); PG8_STAGE(PG8_SB(0, 1), b2 + hstep, voffB); PG8_STAGE(PG8_SA(0, 0), a2, voffA);
            PG8_WAIT_V(8); PG8_WAIT_L(0); PG8_BAR; PG8_MMA(1, 0, At, B0); PG8_MMA(1, 1, At, B1); PG8_BAR; PG8_SCHED;
            PG8_LDB(B0, 1, 0); PG8_LDB(B1, 1, 1); PG8_SCHED; PG8_LDA(At, 1, 0); PG8_STAGE(PG8_SA(0, 1), a2 + hstep, voffA);
            PG8_WAIT_V(8); PG8_WAIT_L(0); PG8_BAR; PG8_MMA(0, 0, At, B0); PG8_MMA(0, 1, At, B1); PG8_BAR; PG8_SCHED;
            PG8_LDA(At, 1, 1); PG8_STAGE(PG8_SB(1, 0), b3, voffB); PG8_STAGE(PG8_SB(1, 1), b3 + hstep, voffB); PG8_STAGE(PG8_SA(1, 0), a3, voffA);
            PG8_WAIT_V(8); PG8_WAIT_L(0); PG8_BAR; PG8_MMA(1, 0, At, B0); PG8_MMA(1, 1, At, B1); PG8_BAR; PG8_SCHED;
            } else {
            PG8_LDB(B0, 0, 0); PG8_SCHED; PG8_LDA(At, 0, 0); PG8_STAGE(PG8_SA(1, 1), a1 + hstep, voffA);
            PG8_WAIT_L(8); PG8_BAR; PG8_WAIT_L(0); PG8_MMA(0, 0, At, B0); PG8_BAR; PG8_SCHED;
            PG8_LDB(B1, 0, 1); PG8_STAGE(PG8_SB(0, 0), b2, voffB);
            PG8_BAR; PG8_WAIT_L(0); PG8_MMA(0, 1, At, B1); PG8_BAR;
            PG8_LDA(At, 0, 1); PG8_STAGE(PG8_SA(0, 0), a2, voffA);
            PG8_BAR; PG8_WAIT_L(0); PG8_MMA(1, 0, At, B0); PG8_BAR; PG8_SCHED;
            PG8_STAGE(PG8_SB(0, 1), b2 + hstep, voffB);
            PG8_WAIT_V(6); PG8_BAR; PG8_MMA(1, 1, At, B1); PG8_BAR;
            PG8_LDB(B0, 1, 0); PG8_SCHED; PG8_LDA(At, 1, 0); PG8_STAGE(PG8_SA(0, 1), a2 + hstep, voffA);
            PG8_WAIT_L(8); PG8_BAR; PG8_WAIT_L(0); PG8_MMA(0, 0, At, B0); PG8_BAR; PG8_SCHED;
            PG8_LDB(B1, 1, 1); PG8_STAGE(PG8_SB(1, 0), b3, voffB);
            PG8_BAR; PG8_WAIT_L(0); PG8_MMA(0, 1, At, B1); PG8_BAR;
            PG8_LDA(At, 1, 1); PG8_STAGE(PG8_SA(1, 0), a3, voffA);
            PG8_BAR; PG8_WAIT_L(0); PG8_MMA(1, 0, At, B0); PG8_BAR; PG8_SCHED;
            PG8_STAGE(PG8_SB(1, 1), b3 + hstep, voffB);
            PG8_WAIT_V(6); PG8_BAR; PG8_MMA(1, 1, At, B1); PG8_BAR;
            }
        }
        if constexpr (ALIGN_EPI) { if (wr == 0) PG8_BAR; }
        if constexpr (!Epi::AFTER_DRAIN) { if constexpr (Epi::PREFETCH) E(acc, cur, wr, wc, fr, fq, ui); else E(acc, cur, wr, wc, fr, fq); S.done(cur); }
        if (!has_next) break;
#pragma unroll
        for (int a = 0; a < 2; ++a)
#pragma unroll
            for (int b = 0; b < 2; ++b)
#pragma unroll
                for (int m = 0; m < 4; ++m)
#pragma unroll
                    for (int n = 0; n < 2; ++n) acc[a][b][m][n] = (f32x4){0.f, 0.f, 0.f, 0.f};
        cur = nxt; cA = nA; cB = nB; ++ui;
        if constexpr (ALIGN_EPI) { if (wr == 1) PG8_BAR; }
    }
    PG8_WAIT_V(0);
    if constexpr (!ALIGN_EPI) { if (wr == 0) PG8_BAR; }
    PG8_BAR;
    if constexpr (Epi::AFTER_DRAIN) { E.fused(acc, cur, wr, wc, fr, fq, lds, wid, lane); S.done(cur); }
#undef PG8_SA
#undef PG8_SB
#undef PG8_STAGE
#undef PG8_LDA
#undef PG8_LDB
#undef PG8_MMA
#undef PG8_WAIT_V
#undef PG8_WAIT_L
#undef PG8_BAR
#undef PG8_SCHED
}
}
#include <hip/hip_bf16.h>
#include <cmath>
namespace attn_body {
using bf16=__hip_bfloat16;
using bf16x8=__attribute__((ext_vector_type(8)))short;
using s16x4=__attribute__((ext_vector_type(4)))short;
using f32x16=__attribute__((ext_vector_type(16)))float;
using u32x4=__attribute__((ext_vector_type(4)))unsigned;
constexpr int D=64,QP=1024,KP=128;
constexpr int NW=8,QBLK=32,QB=QBLK*NW,KVBLK=64;
__device__ __forceinline__ int crow(int r,int hi){return (r&3)+8*(r>>2)+4*hi;}
#define SBAR() __builtin_amdgcn_sched_barrier(0)
__device__ __forceinline__ void cmask(f32x16&p0,f32x16&p1,int jb,int qrel,int hi){
  const float NEG=-INFINITY; int kb=64*jb+4*hi;
  #pragma unroll
  for(int r=0;r<16;++r){int kv=kb+(r&3)+8*(r>>2); if(kv>qrel)p0[r]=NEG; if(kv+32>qrel)p1[r]=NEG;}
}

constexpr int NSLOT=3, SLOTB=8192;
constexpr int LDS_K=0, LDS_V=NSLOT*SLOTB, LDS_WS=2*NSLOT*SLOTB, LDS_OST=LDS_WS+NW*64*4, LDS_BYTES=LDS_OST+NW*4096;
constexpr float C2=0.125f*1.4426950408889634f;
__device__ __forceinline__ void glds16(const void*gsrc,unsigned lds_dst){unsigned keep;
  asm volatile("s_mov_b32 %0, m0\n\ts_mov_b32 m0, %2\n\ts_nop 0\n\tglobal_load_lds_dwordx4 %1, off\n\ts_mov_b32 m0, %0":"=&s"(keep):"v"(gsrc),"s"(lds_dst):"memory");}
__device__ __forceinline__ float max3f(float a,float b,float c){float r;asm("v_max3_f32 %0, %1, %2, %3":"=v"(r):"v"(a),"v"(b),"v"(c));return r;}
__device__ __forceinline__ float max2f(float a,float b){float r;asm("v_max_f32_e32 %0, %1, %2":"=v"(r):"v"(a),"v"(b));return r;}
__device__ __forceinline__ float fadd_s(float a,float b){float r;asm("v_add_f32_e32 %0, %1, %2":"=v"(r):"v"(a),"v"(b));return r;}
__device__ __forceinline__ float fsub_s(float a,float b){float r;asm("v_sub_f32_e32 %0, %1, %2":"=v"(r):"v"(a),"v"(b));return r;}
typedef float f32x2_t __attribute__((ext_vector_type(2))); typedef __bf16 bf16x2_t __attribute__((ext_vector_type(2)));
__device__ __forceinline__ unsigned cvtpk_s(float lo,float hi){f32x2_t v={lo,hi};bf16x2_t b=__builtin_convertvector(v,bf16x2_t);return __builtin_bit_cast(unsigned,b);}
#define WAIT_BAR(N) asm volatile("s_waitcnt vmcnt(" #N ") lgkmcnt(0)\n\ts_barrier":::"memory")

__device__ __forceinline__ void qkt(f32x16&p0,f32x16&p1,const char*Kslot,const bf16x8*qr,const f32x16&negm,int r32,int hi){
  const char*kb=Kslot+hi*1024+r32*16;
  #pragma unroll
  for(int d0=0;d0<4;++d0){
    const bf16x8 b0=*reinterpret_cast<const bf16x8*>(kb+d0*2048);
    const bf16x8 b1=*reinterpret_cast<const bf16x8*>(kb+d0*2048+512);
    if(d0==0){p0=__builtin_amdgcn_mfma_f32_32x32x16_bf16(b0,qr[0],negm,0,0,0);p1=__builtin_amdgcn_mfma_f32_32x32x16_bf16(b1,qr[0],negm,0,0,0);}
    else{p0=__builtin_amdgcn_mfma_f32_32x32x16_bf16(b0,qr[d0],p0,0,0,0);p1=__builtin_amdgcn_mfma_f32_32x32x16_bf16(b1,qr[d0],p1,0,0,0);}}
}
typedef __attribute__((address_space(3))) const char* lds_cptr;
typedef short v4i16_t __attribute__((ext_vector_type(4)));
__device__ __forceinline__ void kload8(bf16x8*kf,lds_cptr kp){
  kf[0]=*(const __attribute__((address_space(3))) bf16x8*)(kp);      kf[1]=*(const __attribute__((address_space(3))) bf16x8*)(kp+512);
  kf[2]=*(const __attribute__((address_space(3))) bf16x8*)(kp+2048); kf[3]=*(const __attribute__((address_space(3))) bf16x8*)(kp+2560);
  kf[4]=*(const __attribute__((address_space(3))) bf16x8*)(kp+4096); kf[5]=*(const __attribute__((address_space(3))) bf16x8*)(kp+4608);
  kf[6]=*(const __attribute__((address_space(3))) bf16x8*)(kp+6144); kf[7]=*(const __attribute__((address_space(3))) bf16x8*)(kp+6656);
}
__device__ __forceinline__ void kload2(bf16x8*kf,lds_cptr kp,int j){ kf[2*j]=*(const __attribute__((address_space(3))) bf16x8*)(kp+j*2048); kf[2*j+1]=*(const __attribute__((address_space(3))) bf16x8*)(kp+j*2048+512); }
__device__ __forceinline__ s16x4 vtr(lds_cptr p){ return __builtin_bit_cast(s16x4,__builtin_amdgcn_ds_read_tr16_b64_v4i16((__attribute__((address_space(3))) v4i16_t*)p)); }
__device__ __forceinline__ float rowmax(const f32x16&p0,const f32x16&p1){
  float a=max3f(p0[0],p0[1],p1[0]),b=max3f(p0[2],p0[3],p1[1]);a=max3f(a,p1[2],p1[3]);
  #pragma unroll
  for(int r=4;r<16;r+=4){a=max3f(a,p0[r],p0[r+1]);b=max3f(b,p0[r+2],p0[r+3]);a=max3f(a,p1[r],p1[r+1]);b=max3f(b,p1[r+2],p1[r+3]);}
  const float m=max2f(a,b);
  auto rr=__builtin_amdgcn_permlane32_swap(__float_as_uint(m),__float_as_uint(m),false,false);
  return max2f(__uint_as_float(rr[0]),__uint_as_float(rr[1]));
}
__device__ __forceinline__ void pv(f32x16*o,int vb,bf16x8 pa0,bf16x8 pa1,bf16x8 pa2,bf16x8 pa3){
  #pragma unroll
  for(int d0=0;d0<2;++d0){s16x4 lo[4],hi[4];
    #pragma unroll
    for(int ks=0;ks<4;++ks){
      asm volatile("ds_read_b64_tr_b16 %0,%1 offset:%c2":"=&v"(lo[ks]):"v"(vb),"i"(d0*4096+ks*1024):"memory");
      asm volatile("ds_read_b64_tr_b16 %0,%1 offset:%c2":"=&v"(hi[ks]):"v"(vb),"i"(d0*4096+ks*1024+512):"memory");}
    asm volatile("s_waitcnt lgkmcnt(0)":::"memory");SBAR();
    #define PK(k) (bf16x8){lo[k][0],lo[k][1],lo[k][2],lo[k][3],hi[k][0],hi[k][1],hi[k][2],hi[k][3]}
    o[d0]=__builtin_amdgcn_mfma_f32_32x32x16_bf16(pa0,PK(0),o[d0],0,0,0);
    o[d0]=__builtin_amdgcn_mfma_f32_32x32x16_bf16(pa1,PK(1),o[d0],0,0,0);
    o[d0]=__builtin_amdgcn_mfma_f32_32x32x16_bf16(pa2,PK(2),o[d0],0,0,0);
    o[d0]=__builtin_amdgcn_mfma_f32_32x32x16_bf16(pa3,PK(3),o[d0],0,0,0);
    #undef PK
  }
}

#ifndef ATTN_STORE16
#define ATTN_STORE16(p,v) (*(u32x4*)(p)=(v))
#endif
template<int THRL> __device__ __forceinline__ void attn_unit(const bf16*Qw0,const bf16*__restrict__ Kh,const bf16*__restrict__ Vh,bf16*Ow0,const int NT,char*shm){
  int tid_=threadIdx.x; asm volatile("":"+v"(tid_)); const int tid=tid_,lane=tid&63,r32=lane&31,hi=lane>>5; const int wid=__builtin_amdgcn_readfirstlane(tid>>6);
  const bf16*Qw=Qw0+(long)(wid*QBLK)*QP;
  const unsigned lds0=(unsigned)(uintptr_t)shm;
  float*wsf=(float*)(shm+LDS_WS)+wid*64;
  const bf16*ksrc=Kh+(long)lane*KP+wid*8;
  const bf16*vsrc=Vh+(long)(16*(wid&3)+(lane>>2))*KP+(wid>>2)*32+(lane&3)*8;
  const unsigned kdst=lds0+LDS_K+wid*1024, vdst=lds0+LDS_V+wid*1024;
  #define DMA_K(t,slot) glds16(ksrc+(long)(t)*KVBLK*KP,(unsigned)__builtin_amdgcn_readfirstlane(kdst+(slot)))
  #define DMA_V(t,slot) glds16(vsrc+(long)(t)*KVBLK*KP,(unsigned)__builtin_amdgcn_readfirstlane(vdst+(slot)))
  const int vb0=(int)(lds0+LDS_V)+((lane>>4)&1)*32+(lane&3)*8+(4*hi+((lane&15)>>2))*64;
  const char*Kbase=shm+LDS_K; bf16x8 kf[8];
  const lds_cptr shm3=(lds_cptr)shm; const lds_cptr kp0=shm3+LDS_K+hi*1024+r32*16; const lds_cptr vp0=shm3+LDS_V+((lane>>4)&1)*32+(lane&3)*8+(4*hi+((lane&15)>>2))*64;
  DMA_K(0,0);DMA_V(0,0);DMA_K(1,SLOTB);
  bf16x8 qr[4];
  #pragma unroll
  for(int d0=0;d0<4;++d0)qr[d0]=*reinterpret_cast<const bf16x8*>(&Qw[(long)r32*QP+d0*16+hi*8]);
  float mhat=0.f,l_reg=0.f;f32x16 o[2];o[0]=f32x16{};o[1]=f32x16{};f32x16 negm=f32x16{};asm volatile("":"+v"(negm));
  #define CMASK(P0,P1,t) do{}while(0)
  bool resc=false;
  #define START(P0,P1) do{ const float rm=rowmax(P0,P1); resc=false; \
    { const float dl=rm; mhat=fadd_s(mhat,dl); \
      _Pragma("unroll") for(int r=0;r<16;++r){P0[r]=fsub_s(P0[r],dl);P1[r]=fsub_s(P1[r],dl);} \
      _Pragma("unroll") for(int r=0;r<16;++r)negm[r]=-mhat; asm volatile("":"+v"(negm)); } \
    _Pragma("unroll") for(int r=0;r<16;++r)P0[r]=__builtin_amdgcn_exp2f(P0[r]); }while(0)
  #define RESC() do{ if(resc){ asm volatile("s_waitcnt lgkmcnt(0)":::"memory"); \
      _Pragma("unroll") for(int d_=0;d_<2;++d_) _Pragma("unroll") for(int r=0;r<16;++r)o[d_][r]*=wsf[crow(r,hi)]; } }while(0)
  f32x16 pA0,pA1,pB0,pB1;
  int sl_prev=0,sl_cur=0,sl_next=SLOTB;
  #define ROT() do{sl_prev=sl_cur;sl_cur=sl_next;sl_next=(sl_next==(NSLOT-1)*SLOTB)?0:sl_next+SLOTB;}while(0)
  DMA_K(2,2*SLOTB);
  WAIT_BAR(3);
  qkt(pA0,pA1,Kbase,qr,negm,r32,hi);asm volatile("s_nop 15\n\ts_nop 7":"+v"(pA0),"+v"(pA1));CMASK(pA0,pA1,0);
  START(pA0,pA1);
  _Pragma("unroll") for(int r=0;r<16;++r)pA1[r]=__builtin_amdgcn_exp2f(pA1[r]);
  WAIT_BAR(0);
  DMA_K(3,0);DMA_V(1,SLOTB);
  ROT();
  kload8(kf,kp0+sl_cur);
  WAIT_BAR(2);
  s16x4 vlo[8],vhi[8]; u32x4 pw0,pw1,pw2,pw3;
  #define PKW(P,B) cvtpk_s(P[B],P[B+1])
  #define PAF(k) __builtin_bit_cast(bf16x8,pw##k)
  #define VFR(i) (bf16x8){vlo[i][0],vlo[i][1],vlo[i][2],vlo[i][3],vhi[i][0],vhi[i][1],vhi[i][2],vhi[i][3]}
  #define PIN(x) asm volatile("":"+v"(x))
  #define MX3(a,b,c) __builtin_fmaxf(__builtin_fmaxf((a),(b)),(c))
  #define GAPA(MF,A0,A1,A2,A3,W0,W1,PW) do{ MF; sacc+=A0; sacc+=A1; sacc+=A2; sacc+=A3; PIN(sacc); W0; W1; PIN(PW); SBAR(); }while(0)
  #define EX(v) __builtin_amdgcn_exp2f(v)
  #define GAPB(MF,X,B) do{ MF; X[B]=EX(X[B]); X[B+1]=EX(X[B+1]); X[B+2]=EX(X[B+2]); X[B+3]=EX(X[B+3]); PIN(X); SBAR(); }while(0)
  #define VRD(i) do{ vlo[i]=vtr(vp_+(((i)>>2)*4096+((i)&3)*1024)); vhi[i]=vtr(vp_+(((i)>>2)*4096+((i)&3)*1024+512)); }while(0)
  #define KRD(G,j) do{ if(G){ kload2(kf,kp0+sl_next,j); SBAR(); } }while(0)
  #define STEP(C0,C1,P0,P1,t,GK,GV,GL) do{ SBAR(); \
    const lds_cptr vp_=vp0+sl_prev; \
    VRD(0); SBAR(); float sacc=(P0[0]+P0[1]); \
    GAPA(C0=__builtin_amdgcn_mfma_f32_32x32x16_bf16(kf[0],qr[0],negm,0,0,0), P0[2],P0[3],P0[4],P0[5],     pw0[0]=PKW(P0,0), pw0[1]=PKW(P0,2), pw0); \
    VRD(4); SBAR(); GAPA(C1=__builtin_amdgcn_mfma_f32_32x32x16_bf16(kf[1],qr[0],negm,0,0,0), P0[6],P0[7],P0[8],P0[9],     pw0[2]=PKW(P0,4), pw0[3]=PKW(P0,6), pw0); \
    VRD(1); SBAR(); GAPA(C0=__builtin_amdgcn_mfma_f32_32x32x16_bf16(kf[2],qr[1],C0,0,0,0),   P0[10],P0[11],P0[12],P0[13], pw1[0]=PKW(P0,8), pw1[1]=PKW(P0,10), pw1); \
    VRD(5); SBAR(); GAPA(C1=__builtin_amdgcn_mfma_f32_32x32x16_bf16(kf[3],qr[1],C1,0,0,0),   P0[14],P0[15],P1[0],P1[1],   pw1[2]=PKW(P0,12),pw1[3]=PKW(P0,14), pw1); \
    VRD(2); SBAR(); GAPA(C0=__builtin_amdgcn_mfma_f32_32x32x16_bf16(kf[4],qr[2],C0,0,0,0),   P1[2],P1[3],P1[4],P1[5],     pw2[0]=PKW(P1,0), pw2[1]=PKW(P1,2), pw2); \
    VRD(6); SBAR(); GAPA(C1=__builtin_amdgcn_mfma_f32_32x32x16_bf16(kf[5],qr[2],C1,0,0,0),   P1[6],P1[7],P1[8],P1[9],     pw2[2]=PKW(P1,4), pw2[3]=PKW(P1,6), pw2); \
    VRD(3); SBAR(); GAPA(C0=__builtin_amdgcn_mfma_f32_32x32x16_bf16(kf[6],qr[3],C0,0,0,0),   P1[10],P1[11],P1[12],P1[13], pw3[0]=PKW(P1,8), pw3[1]=PKW(P1,10), pw3); \
    VRD(7); SBAR(); GAPA(C1=__builtin_amdgcn_mfma_f32_32x32x16_bf16(kf[7],qr[3],C1,0,0,0),   P1[14],P1[15],0.f,0.f,       pw3[2]=PKW(P1,12),pw3[3]=PKW(P1,14), pw3); \
    l_reg+=sacc; \
    if(GK){DMA_K((t)+3,sl_cur);} if(GV){DMA_V((t)+1,sl_next);} \
    CMASK(C0,C1,t); \
    { float a=MX3(C0[0],C0[1],C1[0]),b=MX3(C0[2],C0[3],C1[1]); a=MX3(a,C1[2],C1[3]); \
      _Pragma("unroll") for(int r=4;r<16;r+=4){a=MX3(a,C0[r],C0[r+1]);b=MX3(b,C0[r+2],C0[r+3]);a=MX3(a,C1[r],C1[r+1]);b=MX3(b,C1[r+2],C1[r+3]);} \
      float rm=__builtin_fmaxf(a,b); { auto rr=__builtin_amdgcn_permlane32_swap(__float_as_uint(rm),__float_as_uint(rm),false,false); rm=__builtin_fmaxf(__uint_as_float(rr[0]),__uint_as_float(rr[1])); } \
      resc=false; \
      if(__builtin_expect(__any(rm>(float)THRL),0)){ const float dl=__builtin_fmaxf(rm,0.f); mhat+=dl; \
        _Pragma("unroll") for(int r=0;r<16;++r){C0[r]-=dl;C1[r]-=dl;} \
        _Pragma("unroll") for(int r=0;r<16;++r)negm[r]=-mhat; asm volatile("":"+v"(negm)); \
        const float f=__builtin_amdgcn_exp2f(-dl); l_reg*=f; if(hi==0)wsf[r32]=f; resc=true; } } \
    SBAR(); \
    GAPB(o[0]=__builtin_amdgcn_mfma_f32_32x32x16_bf16(PAF(0),VFR(0),o[0],0,0,0), C0,0); \
    GAPB(o[1]=__builtin_amdgcn_mfma_f32_32x32x16_bf16(PAF(0),VFR(4),o[1],0,0,0), C0,4); \
    KRD(GL,0); GAPB(o[0]=__builtin_amdgcn_mfma_f32_32x32x16_bf16(PAF(1),VFR(1),o[0],0,0,0), C0,8); \
    KRD(GL,1); GAPB(o[1]=__builtin_amdgcn_mfma_f32_32x32x16_bf16(PAF(1),VFR(5),o[1],0,0,0), C0,12); \
    KRD(GL,2); GAPB(o[0]=__builtin_amdgcn_mfma_f32_32x32x16_bf16(PAF(2),VFR(2),o[0],0,0,0), C1,0); \
    KRD(GL,3); GAPB(o[1]=__builtin_amdgcn_mfma_f32_32x32x16_bf16(PAF(2),VFR(6),o[1],0,0,0), C1,4); \
    GAPB(o[0]=__builtin_amdgcn_mfma_f32_32x32x16_bf16(PAF(3),VFR(3),o[0],0,0,0), C1,8); \
    GAPB(o[1]=__builtin_amdgcn_mfma_f32_32x32x16_bf16(PAF(3),VFR(7),o[1],0,0,0), C1,12); \
    }while(0)
  int t=1;
  for(;t+5<NT;t+=2){
    STEP(pB0,pB1,pA0,pA1,t,true,true,true);     WAIT_BAR(2); RESC(); ROT();
    STEP(pA0,pA1,pB0,pB1,t+1,true,true,true);   WAIT_BAR(2); RESC(); ROT();
  }
  #define ENDW(tt) do{ if((tt)+3<NT){WAIT_BAR(2);} else if((tt)+2<NT){WAIT_BAR(1);} else {WAIT_BAR(0);} }while(0)
  for(;t+1<NT;t+=2){
    STEP(pB0,pB1,pA0,pA1,t,(t+3<NT),(t+1<NT),(t+1<NT));       ENDW(t);   RESC(); ROT();
    STEP(pA0,pA1,pB0,pB1,t+1,(t+4<NT),(t+2<NT),(t+2<NT));     ENDW(t+1); RESC(); ROT();
  }
  STEP(pB0,pB1,pA0,pA1,NT-1,false,false,false); RESC();
  { float sacc=pB0[0]+pB0[1]; _Pragma("unroll") for(int r=2;r<16;++r)sacc+=pB0[r]; _Pragma("unroll") for(int r=0;r<16;++r)sacc+=pB1[r]; l_reg+=sacc;
    pw0=(u32x4){PKW(pB0,0),PKW(pB0,2),PKW(pB0,4),PKW(pB0,6)};pw1=(u32x4){PKW(pB0,8),PKW(pB0,10),PKW(pB0,12),PKW(pB0,14)};pw2=(u32x4){PKW(pB1,0),PKW(pB1,2),PKW(pB1,4),PKW(pB1,6)};pw3=(u32x4){PKW(pB1,8),PKW(pB1,10),PKW(pB1,12),PKW(pB1,14)};
    SBAR(); pv(o,vb0+sl_cur,PAF(0),PAF(1),PAF(2),PAF(3)); }
  #undef PKW
  #undef PAF
  #undef VFR
  #undef PIN
  #undef MX3
  #undef GAPA
  #undef GAPB
  #undef EX
  #undef VRD
  #undef KRD
  #undef STEP
  #undef ENDW
  {auto rr=__builtin_amdgcn_permlane32_swap(__float_as_uint(l_reg),__float_as_uint(l_reg),false,false);l_reg=__uint_as_float(rr[0])+__uint_as_float(rr[1]);}
  if(hi==0)wsf[32+r32]=l_reg;asm volatile("s_waitcnt lgkmcnt(0)":::"memory");
  float rli[16];
  #pragma unroll
  for(int r=0;r<16;++r)rli[r]=__builtin_amdgcn_rcpf(wsf[32+crow(r,hi)]);
  bf16*Ow=Ow0+(long)(wid*QBLK)*QP;
  { bf16*stg=(bf16*)(shm+LDS_OST)+wid*2048;
    #pragma unroll
    for(int r=0;r<16;++r){const int orow=crow(r,hi);
      #pragma unroll
      for(int d0=0;d0<2;++d0)stg[orow*64+d0*32+r32]=__float2bfloat16(o[d0][r]*rli[r]);}
    asm volatile("s_waitcnt lgkmcnt(0)":::"memory");
    #pragma unroll
    for(int i=0;i<4;++i){const int row=i*8+(lane>>3),ch=lane&7; const u32x4 v=*(const u32x4*)(stg+row*64+ch*8); ATTN_STORE16(Ow+(long)row*QP+ch*8,v);} }
  asm volatile("s_waitcnt lgkmcnt(0)\n\ts_barrier":::"memory");
  #undef DMA_K
  #undef DMA_V
  #undef CMASK
  #undef START
  #undef RESC
  #undef ROT
}
constexpr int ATTN_LDS_BYTES=LDS_BYTES;
#undef SBAR
#undef WAIT_BAR
}
constexpr int NWAVES = 8, NTHR = 512;
constexpr int DMODEL = 1024, NBATCH = 8, SEQ = 2048, CTXL = 256, DEPTH = 2;
constexpr int NLAT = NBATCH * SEQ, NCTX = NBATCH * CTXL, MT = NLAT + NCTX;
constexpr int INW = 1536, FF = 2816, NKEY = CTXL + SEQ, KVW = 128, MODW = 6144;
constexpr int O_K = 512, O_V = 640, O_G = 768, O_P = 1280;
constexpr float EPS = 1e-6f;
constexpr size_t MiB = 1u << 20;
constexpr size_t WS_CTL = 0, CTL_ZERO_BYTES = 1 * MiB + 128 * 1024;
constexpr size_t WS_MOD = 64 * 1024;
constexpr size_t WS_BIASIN = 1 * MiB;
constexpr size_t WS_ROPE = 1 * MiB + 128 * 1024;
constexpr size_t WS_WS = WS_ROPE + 512 * 1024;
constexpr size_t WS_PW = WS_WS + 256 * 1024;
constexpr size_t WS_WIN = 2 * MiB, WS_WOUT = 8 * MiB, WS_WGU = 12 * MiB, WS_WDN = 34 * MiB;
constexpr size_t WS_CTXRES = 45 * MiB;
constexpr size_t WS_H = 53 * MiB;
constexpr size_t WS_ACT = 89 * MiB;
constexpr size_t WS_Z = 89 * MiB, WS_MIX = 143 * MiB, WS_KB = 179 * MiB, WS_VB = WS_KB + 4608 * 1024;
constexpr size_t WS_BIAS = 188 * MiB;
constexpr size_t WS_END = 189 * MiB;
constexpr size_t WS_SLAB = 192 * MiB; constexpr int KSPLIT = 4;
constexpr size_t WS_XH = 224 * MiB;
static_assert(WS_SLAB + (size_t)32 * KSPLIT * 65536 * 4 <= WS_XH && WS_XH + (size_t)NLAT * DMODEL * 2 <= 256 * MiB, "slabs / fp16 stream inside 256 MiB");
constexpr size_t WS_RSSV = 872 * 1024;
constexpr size_t WS_RSS = 512 * 1024;
static_assert((4096 + 3456) * 4 <= 64 * 1024, "barrier words below the mod accumulators");
static_assert(WS_BIASIN + (size_t)DEPTH * 9 * INW * 4 <= CTL_ZERO_BYTES && WS_PW + (size_t)DEPTH * 4 * 64 * 64 * 2 <= WS_WIN && CTL_ZERO_BYTES <= WS_ROPE, "bias_in accumulators / small tables");
static_assert(WS_MOD + (size_t)DEPTH * 9 * MODW * 4 <= WS_RSS && WS_RSS + (size_t)5 * MT * 4 <= WS_RSSV && WS_RSSV + (size_t)DEPTH * MT * 4 <= CTL_ZERO_BYTES, "mod / rss inside memset region");
static_assert(WS_Z + (size_t)MT * INW * 2 <= WS_MIX && WS_MIX + (size_t)MT * 1024 * 2 <= WS_KB && WS_VB + (size_t)NBATCH * NKEY * KVW * 2 <= WS_END && WS_ACT + (size_t)MT * FF * 2 <= WS_END, "ws map");
static_assert(WS_WIN + (size_t)DEPTH * INW * 1024 * 2 <= WS_WOUT && WS_WOUT + (size_t)DEPTH * 1024 * 1024 * 2 <= WS_WGU && WS_WGU + (size_t)DEPTH * 2 * FF * 1024 * 2 <= WS_WDN && WS_WDN + (size_t)DEPTH * 1024 * FF * 2 <= WS_CTXRES, "ws map 2");
constexpr int LDSCTL_OFF = 131072, MISC_OFF = LDSCTL_OFF + 320;
constexpr int LDS_BYTES = 147456;

#define LAS __attribute__((address_space(3)))
typedef unsigned short bf16;
typedef unsigned v4u __attribute__((ext_vector_type(4)));
typedef unsigned v2u __attribute__((ext_vector_type(2)));
typedef float f32x4 __attribute__((ext_vector_type(4)));
typedef short bf16x8 __attribute__((ext_vector_type(8)));
#define LDS_WAIT() asm volatile("s_waitcnt lgkmcnt(0)" ::: "memory")
__device__ __forceinline__ unsigned f2bf(float f) { unsigned u = __builtin_bit_cast(unsigned, f); return (u + 0x7fffu + ((u >> 16) & 1u)) >> 16; }
__device__ __forceinline__ unsigned pk2(float lo, float hi) { return f2bf(lo) | (f2bf(hi) << 16); }
__device__ __forceinline__ float bflo(unsigned w) { return __builtin_bit_cast(float, w << 16); }
__device__ __forceinline__ float bfhi(unsigned w) { return __builtin_bit_cast(float, w & 0xffff0000u); }
__device__ __forceinline__ void unpack8(const v4u r, float (&f)[8]) { f[0] = bflo(r.x); f[1] = bfhi(r.x); f[2] = bflo(r.y); f[3] = bfhi(r.y); f[4] = bflo(r.z); f[5] = bfhi(r.z); f[6] = bflo(r.w); f[7] = bfhi(r.w); }
__device__ __forceinline__ v4u pack8(const float (&f)[8]) { v4u o; o.x = pk2(f[0], f[1]); o.y = pk2(f[2], f[3]); o.z = pk2(f[4], f[5]); o.w = pk2(f[6], f[7]); return o; }
__device__ __forceinline__ float wave_sum(float v) {
#pragma unroll
    for (int o = 1; o < 64; o <<= 1) v += __shfl_xor(v, o);
    return v;
}
__device__ __forceinline__ float gelu_tanh(float x) {
    const float y = 0.7978845608028654f * (x + 0.044715f * x * x * x);
    const float e = __builtin_amdgcn_exp2f(y * -2.8853900817779268f);
    return x * __builtin_amdgcn_rcpf(1.0f + e);
}

#define RLX_AGENT __ATOMIC_RELAXED, __HIP_MEMORY_SCOPE_AGENT
#define XB_TMO      128
#define XB_XCNT(j)  (256  + 64 * (j))
#define XB_XSUB(j)  (1280 + 64 * (j))
#define XB_XGEN(j)  (2304 + 64 * (j))
#define XB_TOP      3328
#define XB_TOPGEN   3392
#define XCD_BAR_WORDS 3456
#define XB_SPIN_CAP (1u << 18)

__device__ __forceinline__ unsigned xb_ld(unsigned* p)              { return __hip_atomic_load(p, __ATOMIC_RELAXED, __HIP_MEMORY_SCOPE_AGENT); }
__device__ __forceinline__ unsigned xb_add(unsigned* p, unsigned v) { return __hip_atomic_fetch_add(p, v, __ATOMIC_RELAXED, __HIP_MEMORY_SCOPE_AGENT); }
__device__ __forceinline__ unsigned xb_xcc_id() { return (unsigned)__builtin_amdgcn_s_getreg((3 << 11) | 20) & 0xFu; }
#define XB_SPIN(cond, bar) do { unsigned _sp = 0; while (cond) { __builtin_amdgcn_s_sleep(1); \
    if ((++_sp & 255u) == 0u) { if (xb_ld(&(bar)[XB_TMO])) break; if (_sp > XB_SPIN_CAP) { atomicAdd(&(bar)[XB_TMO], 1u); break; } } } } while (0)

struct XcdBarrier {
    unsigned* bar; unsigned x;
    volatile LAS unsigned* st;
};

__device__ __forceinline__ XcdBarrier xcd_barrier_post(unsigned* bar, volatile LAS unsigned* st) {
    XcdBarrier b; b.bar = bar; b.x = xb_xcc_id(); b.st = st;
    if (threadIdx.x == 0) (void)xb_add(&bar[XB_XCNT(b.x)], 1u);
    return b;
}
__device__ __forceinline__ void xcd_barrier_complete(unsigned* bar, unsigned x, unsigned& nloc, unsigned& nx) {
    const unsigned G = gridDim.x * gridDim.y * gridDim.z;
    unsigned sum, cnt, mine, sp = 0u;
    for (;;) {
        sum = 0u; cnt = 0u; mine = 0u;
#pragma unroll
        for (unsigned j = 0; j < 16; ++j) { const unsigned c = xb_ld(&bar[XB_XCNT(j)]); sum += c; cnt += (c > 0u) ? 1u : 0u; mine = (j == x) ? c : mine; }
        if (sum == G) break;
        __builtin_amdgcn_s_sleep(1);
        if ((++sp & 255u) == 0u) { if (xb_ld(&bar[XB_TMO])) break; if (sp > XB_SPIN_CAP) { atomicAdd(&bar[XB_TMO], 1u); break; } }
    }
    nloc = mine > 0u ? mine : 1u; nx = cnt > 0u ? cnt : 1u;
}

__device__ __forceinline__ void xcd_barrier(const XcdBarrier& b) {
    asm volatile("s_waitcnt vmcnt(0)" ::: "memory");
    __syncthreads();
    if (threadIdx.x == 0) {
        unsigned* bar = b.bar;
        __builtin_amdgcn_s_waitcnt(0);
        unsigned nloc = b.st[0], nx = b.st[1];
        if (nloc == 0u) { xcd_barrier_complete(bar, b.x, nloc, nx); b.st[0] = nloc; b.st[1] = nx; }
        const unsigned old = xb_add(&bar[XB_XSUB(b.x)], 1u);
        const unsigned gen = old / nloc;
        if (old + 1u == (gen + 1u) * nloc) {
            __builtin_amdgcn_fence(__ATOMIC_RELEASE, "agent");
            asm volatile("s_waitcnt vmcnt(0)" ::: "memory");
            const unsigned og = xb_add(&bar[XB_TOP], 1u);
            const unsigned tg = og / nx;
            if (og + 1u == (tg + 1u) * nx) xb_add(&bar[XB_TOPGEN], 1u);
            else XB_SPIN(xb_ld(&bar[XB_TOPGEN]) == tg, bar);
            __builtin_amdgcn_fence(__ATOMIC_ACQUIRE, "agent");
            xb_add(&bar[XB_XGEN(b.x)], 1u);
            asm volatile("s_waitcnt vmcnt(0)" ::: "memory");
        } else {
            XB_SPIN(xb_ld(&bar[XB_XGEN(b.x)]) == gen, bar);
            __builtin_amdgcn_fence(__ATOMIC_ACQUIRE, "agent");
            asm volatile("s_waitcnt vmcnt(0)" ::: "memory");
        }
    }
    __syncthreads();
}

constexpr int CW_PANEL = 8192;
constexpr int CW_BAR = 4096;
struct Args { const float* in[21]; float* out; unsigned char* ws; unsigned long long pad; };
struct Frame {
    LAS unsigned char* lds;
    int tid, lane, wave, vcu, G;
    float* out; unsigned char* ws;
};

__device__ __forceinline__ void relaunder(Frame& F) { int t = threadIdx.x; asm volatile("" : "+v"(t)); F.tid = t; F.lane = t & 63; F.wave = __builtin_amdgcn_readfirstlane(t >> 6); }
__device__ __forceinline__ void p0_transpose_item(const float* W, int K, int N, bf16* WT, int k0, int n0, int drow0, LAS float* scr, int lane) {
    float tv[32];
#pragma unroll
    for (int i = 0; i < 32; ++i) tv[i] = W[(size_t)(k0 + 2 * i + (lane >> 5)) * N + n0 + (lane & 31)];
#pragma unroll
    for (int i = 0; i < 32; ++i) scr[(2 * i + (lane >> 5)) * 33 + (lane & 31)] = tv[i];
    LDS_WAIT(); asm volatile("" ::: "memory");
    const int c = lane & 7;
#pragma unroll
    for (int j = 0; j < 4; ++j) { const int n = (lane >> 3) + 8 * j; const LAS float* s = scr + (8 * c) * 33 + n;
        v4u o; o.x = pk2(s[0 * 33], s[1 * 33]); o.y = pk2(s[2 * 33], s[3 * 33]); o.z = pk2(s[4 * 33], s[5 * 33]); o.w = pk2(s[6 * 33], s[7 * 33]);
        *(v4u*)(WT + (size_t)(drow0 + n) * K + k0 + 8 * c) = o; }
    LDS_WAIT(); asm volatile("" ::: "memory");
}
__device__ __forceinline__ void norm_phase(Frame& F, const float* lat, const float* ctx, int nrows, const float* g, const float* modl, int sc_off, bf16* H, float* rss);
__device__ __forceinline__ void transpose_set(const Args& A, Frame& F, int set, int widx, int nw) {
    LAS float* scr = (LAS float*)(F.lds + F.wave * 16384);
    constexpr int I_IN = 16 * 48, I_OUT = 16 * 32, I_G = 16 * 88, I_D = 44 * 32;
    const int total = set == 0 ? 2 * I_IN + I_OUT : set == 1 ? 2 * I_G + I_D + I_OUT : 2 * I_G + I_D;
    for (int it = widx; it < total; it += nw) {
        int r = it, kind, l;
        if (set == 0) { if (r < 2 * I_IN) { kind = 0; l = r / I_IN; r %= I_IN; } else { kind = 1; l = 0; r -= 2 * I_IN; } }
        else { l = set - 1; if (r < 2 * I_G) kind = 2; else if (r < 2 * I_G + I_D) { kind = 3; r -= 2 * I_G; } else { kind = 1; l = 1; r -= 2 * I_G + I_D; } }
        if (kind == 0) { const int kb = r / 48, nb = r % 48; p0_transpose_item(A.in[8] + (size_t)l * 1024 * INW, 1024, INW, (bf16*)(F.ws + WS_WIN) + (size_t)l * INW * 1024, 64 * kb, 32 * nb, 32 * nb, scr, F.lane); }
        else if (kind == 1) { const int kb = r / 32, nb = r % 32; p0_transpose_item(A.in[16] + (size_t)l * 1024 * 1024, 1024, 1024, (bf16*)(F.ws + WS_WOUT) + (size_t)l * 1024 * 1024, 64 * kb, 32 * nb, 32 * nb, scr, F.lane); }
        else if (kind == 2) { const int up = r >= I_G; if (up) r -= I_G; const int kb = r / 88, nb = r % 88, n0 = 32 * nb;
            p0_transpose_item(A.in[up ? 18 : 17] + (size_t)l * 1024 * FF, 1024, FF, (bf16*)(F.ws + WS_WGU) + (size_t)l * 2 * FF * 1024, 64 * kb, n0, 256 * (n0 >> 7) + (n0 & 127) + (up ? 128 : 0), scr, F.lane); }
        else { const int kb = r / 32, nb = r % 32; p0_transpose_item(A.in[19] + (size_t)l * FF * 1024, FF, 1024, (bf16*)(F.ws + WS_WDN) + (size_t)l * 1024 * FF, 64 * kb, 32 * nb, 32 * nb, scr, F.lane); }
    }
}
__device__ __forceinline__ void tail_transposes(const Args& A, Frame& F, int set, int nwg) {
    relaunder(F);
    const int G = F.G, rounds = (nwg + G - 1) / G; int first_idle = nwg - G * (rounds - 1); if (first_idle >= G) first_idle = 0;
    if ((int)blockIdx.x >= first_idle) transpose_set(A, F, set, ((int)blockIdx.x - first_idle) * NWAVES + F.wave, (G - first_idle) * NWAVES);
}
__device__ __forceinline__ void p0_prologue(const Args& A, Frame& F) {
    relaunder(F);
    const int gw = F.vcu * NWAVES + F.wave, NGW = F.G * NWAVES;
    const int gt = F.vcu * NTHR + F.tid, NGT = F.G * NTHR;
    LAS float* S = (LAS float*)F.lds;
    {   f32x4 cv[5];
#pragma unroll
        for (int i = 0; i < 5; ++i) { const int q = min(F.tid + NTHR * i, 2303); cv[i] = q < 2048 ? *(const f32x4*)(A.in[1] + 4 * q) : *(const f32x4*)(A.in[3] + 4 * (q - 2048)); }
#pragma unroll
        for (int i = 0; i < 5; ++i) { const int q = F.tid + NTHR * i; if (q < 2304) { f32x4 o;
#pragma unroll
            for (int e = 0; e < 4; ++e) o[e] = cv[i][e] * __builtin_amdgcn_rcpf(1.0f + __builtin_amdgcn_exp2f(cv[i][e] * -1.4426950408889634f));
            *(LAS f32x4*)(S + 4 * q) = o; } }
    }
    __syncthreads();
    float* mod = (float*)(F.ws + WS_MOD);
    constexpr int MOD_KS = 16, MOD_KL = 1024 / MOD_KS, MOD_ITEMS = DEPTH * (MODW / 64) * MOD_KS;
    unsigned* mod_cnt = (unsigned*)(F.ws + WS_CTL) + 64 * 10;
    for (int it = gw; it < MOD_ITEMS; it += NGW) {
        const int ks = it % MOD_KS, cgp = (it / MOD_KS) % (MODW / 64), l = it / (MOD_KS * (MODW / 64));
        const int n = cgp * 64 + F.lane, k0 = ks * MOD_KL;
        const float* wp = A.in[4] + (size_t)l * 1024 * MODW + (size_t)k0 * MODW + n;
        float a[9];
#pragma unroll
        for (int r = 0; r < 9; ++r) a[r] = 0.f;
#pragma unroll 16
        for (int kk = 0; kk < MOD_KL; ++kk) { const float w = wp[(size_t)kk * MODW];
#pragma unroll
            for (int r = 0; r < 9; ++r) a[r] += S[r * 1024 + k0 + kk] * w; }
        if (ks == 0) { const float bv = A.in[5][l * MODW + n];
#pragma unroll
            for (int r = 0; r < 9; ++r) a[r] += bv; }
#pragma unroll
        for (int r = 0; r < 9; ++r) atomicAdd(mod + ((size_t)l * 9 + r) * MODW + n, a[r]);
    }
    asm volatile("s_waitcnt vmcnt(0)" ::: "memory");
    __syncthreads();
    if (F.tid == 0) { __builtin_amdgcn_fence(__ATOMIC_RELEASE, "agent"); asm volatile("s_waitcnt vmcnt(0)" ::: "memory");
        __hip_atomic_fetch_add(mod_cnt, 1u, __ATOMIC_RELAXED, __HIP_MEMORY_SCOPE_AGENT); }
    float* rc = (float*)(F.ws + WS_ROPE); float* rs = rc + SEQ * 32;
    for (int i = gt; i < SEQ * 32; i += NGT) { const int tok = i >> 5, p = i & 31; const float pos = (float)(p < 16 ? (tok >> 6) : (tok & 63));
        const float inv = exp2f(-(float)(p & 15) * (13.287712379549449f / 16.0f));
        const float ang = pos * inv; const float nrev = rintf(ang * 0.15915494309189535f);
        float r = fmaf(-nrev, 6.2831855f, ang); r = fmaf(-nrev, -1.7484555e-7f, r);
        rc[i] = __cosf(r); rs[i] = __sinf(r); }
    bf16* wsb = (bf16*)(F.ws + WS_WS);
    for (int i = gt; i < DEPTH * 4 * 128 * 128; i += NGT) wsb[i] = (bf16)f2bf(A.in[12][i]);
    bf16* pwb = (bf16*)(F.ws + WS_PW);
    for (int i = gt; i < DEPTH * 4 * 64 * 64; i += NGT) { const int c = i & 63, d = (i >> 6) & 63, lg = i >> 12; pwb[i] = (bf16)f2bf(A.in[14][(size_t)lg * 4096 + c * 64 + d]); }
    transpose_set(A, F, 0, gw, NGW);
    if (F.tid == 0) { unsigned sp = 0;
        while (__hip_atomic_load(mod_cnt, __ATOMIC_RELAXED, __HIP_MEMORY_SCOPE_AGENT) < (unsigned)F.G) { __builtin_amdgcn_s_sleep(2); if (++sp > (1u << 20)) break; }
        __builtin_amdgcn_fence(__ATOMIC_ACQUIRE, "agent"); asm volatile("s_waitcnt vmcnt(0)" ::: "memory"); }
    __syncthreads();
    norm_phase(F, A.in[0], A.in[2], MT, A.in[6], mod, 1024, (bf16*)(F.ws + WS_H), (float*)(F.ws + WS_RSS) + 3 * MT);
    relaunder(F);
    __syncthreads();
    {   LAS float* SH = (LAS float*)F.lds;
        f32x4 tv[9];
#pragma unroll
        for (int i = 0; i < 9; ++i) { const int q = F.tid + NTHR * i, row = q >> 8, c4 = q & 255; tv[i] = *(const f32x4*)(mod + (size_t)(row / 9) * 9 * MODW + (size_t)(row % 9) * MODW + 4 * c4); }
#pragma unroll
        for (int i = 0; i < 9; ++i) { const int q = F.tid + NTHR * i; *(LAS f32x4*)(SH + 4 * q) = tv[i]; }
        __syncthreads();
        float* bacc = (float*)(F.ws + WS_BIASIN);
        const int gw2 = F.vcu * NWAVES + F.wave;
        for (int it = gw2; it < DEPTH * (INW / 64) * 16; it += NGW) {
            const int ks = it & 15, cgp = (it >> 4) % (INW / 64), l = it / (16 * (INW / 64));
            const int n = cgp * 64 + F.lane, k0 = ks * 64;
            const float* wp = A.in[8] + (size_t)l * 1024 * INW + (size_t)k0 * INW + n;
            float a[9];
#pragma unroll
            for (int r = 0; r < 9; ++r) a[r] = 0.f;
#pragma unroll
            for (int h2 = 0; h2 < 64; h2 += 32) { float wv[32];
#pragma unroll
                for (int kk = 0; kk < 32; ++kk) wv[kk] = wp[(size_t)(h2 + kk) * INW];
#pragma unroll
                for (int kq = 0; kq < 32; ++kq) {
#pragma unroll
                    for (int r = 0; r < 9; ++r) a[r] += SH[(l * 9 + r) * 1024 + k0 + h2 + kq] * wv[kq]; } }
#pragma unroll
            for (int r = 0; r < 9; ++r) atomicAdd(bacc + ((size_t)l * 9 + r) * INW + n, a[r]);
        }
    }
}

__device__ __forceinline__ void norm_phase(Frame& F, const float* lat, const float* ctx, int nrows, const float* g, const float* modl, int sc_off, bf16* H, float* rss) {
    relaunder(F);
    const int gw = F.vcu * NWAVES + F.wave, NGW = F.G * NWAVES;
    for (int row = gw; row < nrows; row += NGW) {
        const bool isl = row < NLAT; const int b = isl ? (row >> 11) : 8;
        const f32x4* xr = (const f32x4*)(isl ? lat + (size_t)row * DMODEL : ctx + (size_t)(row - NLAT) * DMODEL) + F.lane;
        f32x4 v[4]; float s = 0.f;
#pragma unroll
        for (int j = 0; j < 4; ++j) { v[j] = xr[64 * j]; s += (v[j].x * v[j].x + v[j].y * v[j].y) + (v[j].z * v[j].z + v[j].w * v[j].w); }
        s = wave_sum(s);
        if (F.lane == 0) rss[row] = s;
        const f32x4* g4 = (const f32x4*)g + F.lane; const f32x4* sc4 = (const f32x4*)(modl + (size_t)b * MODW + sc_off) + F.lane;
        v2u* o8 = (v2u*)(H + (size_t)row * DMODEL) + F.lane;
#pragma unroll
        for (int j = 0; j < 4; ++j) { const f32x4 y = v[j] * g4[64 * j] * (sc4[64 * j] + 1.0f); v2u o; o.x = pk2(y.x, y.y); o.y = pk2(y.z, y.w); o8[64 * j] = o; }
    }
}
__device__ __forceinline__ void ctx_combine_phase(Frame& F, const float* slabs, const float* base_ctx, float* out_ctx, const float* gate, const float* gn, const float* scn, bf16* H, float* rss) {
    relaunder(F);
    const int gw = F.vcu * NWAVES + F.wave, NGW = F.G * NWAVES, lane = F.lane;
    for (int R = gw; R < NCTX; R += NGW) {
        const int pmc = R >> 8, r = R & 255;
        f32x4 sv[4][KSPLIT], bv[4];
#pragma unroll
        for (int j = 0; j < 4; ++j) { bv[j] = *(const f32x4*)(base_ctx + (size_t)R * DMODEL + 256 * j + 4 * lane);
#pragma unroll
            for (int q = 0; q < KSPLIT; ++q) sv[j][q] = *(const f32x4*)(slabs + (size_t)((j * 8 + pmc) * KSPLIT + q) * 65536 + (size_t)r * 256 + 4 * lane); }
        float ss = 0.f; f32x4 x[4];
#pragma unroll
        for (int j = 0; j < 4; ++j) { f32x4 a = sv[j][0];
#pragma unroll
            for (int q = 1; q < KSPLIT; ++q) a += sv[j][q];
            x[j] = bv[j] + *(const f32x4*)(gate + 8 * MODW + 256 * j + 4 * lane) * a;
            ss += (x[j].x * x[j].x + x[j].y * x[j].y) + (x[j].z * x[j].z + x[j].w * x[j].w); }
        ss = wave_sum(ss);
        if (lane == 0) rss[NLAT + R] = ss;
#pragma unroll
        for (int j = 0; j < 4; ++j) { const int c = 256 * j + 4 * lane; *(f32x4*)(out_ctx + (size_t)R * DMODEL + c) = x[j];
            const f32x4 y = x[j] * *(const f32x4*)(gn + c) * (*(const f32x4*)(scn + 8 * MODW + c) + 1.0f); v2u o; o.x = pk2(y.x, y.y); o.y = pk2(y.z, y.w); *(v2u*)(H + (size_t)(NLAT + R) * DMODEL + c) = o; }
    }
}
__device__ __forceinline__ void bias_phase(Frame& F, const float* mod, int sel) {
    relaunder(F);
    LAS bf16* S = (LAS bf16*)F.lds;
    constexpr int SP = 1032;
    {
        f32x4 tv[18];
#pragma unroll
        for (int i = 0; i < 18; ++i) { const int q = F.tid + NTHR * i, row = q >> 8, c4 = q & 255, tb = row / 9, r = row % 9;
            tv[i] = *(const f32x4*)(mod + (size_t)(tb >> 1) * 9 * MODW + (size_t)r * MODW + ((tb & 1) ? 3072 : 0) + 4 * c4); }
#pragma unroll
        for (int i = 0; i < 18; ++i) { const int q = F.tid + NTHR * i, row = q >> 8, c4 = q & 255, tb = row / 9, r = row % 9;
            v2u o; o.x = pk2(tv[i].x, tv[i].y); o.y = pk2(tv[i].z, tv[i].w); *(LAS v2u*)(S + (tb * 10 + r) * SP + 4 * c4) = o; }
#pragma unroll
        for (int i = 0; i < 2; ++i) { const int q = F.tid + NTHR * i, tb = q >> 8, c4 = q & 255; *(LAS v2u*)(S + (tb * 10 + 9) * SP + 4 * c4) = (v2u){0u, 0u}; }
    }
    __syncthreads();
    const int gw = F.vcu * NWAVES + F.wave, NGW = F.G * NWAVES, lane = F.lane, fr = lane & 15, fq = lane >> 4;
    constexpr int IT_IN = INW / 16, IT_GU = 2 * FF / 16;
    const int nit = sel < 0 ? DEPTH * IT_IN : IT_GU;
    for (int it = gw; it < nit; it += NGW) {
        const int gu = sel >= 0, l = gu ? sel : it / IT_IN; int r = gu ? it : it % IT_IN; const int NR = gu ? 2 * FF : INW;
        const bf16* Wt = (gu ? (const bf16*)(F.ws + WS_WGU) + (size_t)l * 2 * FF * 1024 : (const bf16*)(F.ws + WS_WIN) + (size_t)l * INW * 1024) + (size_t)(16 * r + fr) * 1024 + 8 * fq;
        const LAS bf16* Sp = S + ((l * 2 + gu) * 10 + (fr < 9 ? fr : 9)) * SP + 8 * fq;
        f32x4 acc = (f32x4){0.f, 0.f, 0.f, 0.f};
#pragma unroll 8
        for (int kk = 0; kk < 32; ++kk) { const bf16x8 a = *(const LAS bf16x8*)(Sp + 32 * kk); const bf16x8 bfr = *(const bf16x8*)(Wt + 32 * kk); acc = __builtin_amdgcn_mfma_f32_16x16x32_bf16(a, bfr, acc, 0, 0, 0); }
        float* bo = (float*)(F.ws + WS_BIAS) + (gu ? (size_t)DEPTH * 9 * INW + (size_t)l * 9 * 2 * FF : (size_t)l * 9 * INW);
#pragma unroll
        for (int i = 0; i < 4; ++i) { const int rr = 4 * fq + i; if (rr < 9) bo[(size_t)rr * NR + 16 * r + fr] = acc[i]; }
    }
    __syncthreads();
}
__device__ __forceinline__ void final_norm_phase(Frame& F, const unsigned short* xh, float* out, const float* g) {
    relaunder(F);
    const int gw = F.vcu * NWAVES + F.wave, NGW = F.G * NWAVES;
    for (int row = gw; row < NLAT; row += NGW) {
        f32x4 v[4];
#pragma unroll
        for (int j = 0; j < 2; ++j) { const v4u w = *(const v4u*)(xh + (size_t)row * DMODEL + 512 * j + 8 * F.lane); pg8::unpack_h8(w, v[2 * j], v[2 * j + 1]); }
        float s = 0.f;
#pragma unroll
        for (int j = 0; j < 4; ++j) s += (v[j].x * v[j].x + v[j].y * v[j].y) + (v[j].z * v[j].z + v[j].w * v[j].w);
        const float rstd = 1.0f / sqrtf(wave_sum(s) * (1.f / DMODEL) + EPS);
#pragma unroll
        for (int j = 0; j < 2; ++j) { const int c = 512 * j + 8 * F.lane; float* o = out + (size_t)row * DMODEL + c;
            *(f32x4*)o = (v[2 * j] * rstd) * *(const f32x4*)(g + c); *(f32x4*)(o + 4) = (v[2 * j + 1] * rstd) * *(const f32x4*)(g + c + 4); }
    }
}

__device__ __forceinline__ void prep_qkv(const Args& A, Frame& F, int l, const bf16* Z, bf16* MIX, bf16* KB, bf16* VB) {
    relaunder(F);
    const int gw = F.vcu * NWAVES + F.wave, NGW = F.G * NWAVES, lane = F.lane;
    const float* rc = (const float*)(F.ws + WS_ROPE); const float* rs = rc + SEQ * 32;
    const int j = lane & 7;
    float qn_[8], kn_[8];
#pragma unroll
    for (int e = 0; e < 8; ++e) { qn_[e] = A.in[9][l * 64 + 8 * j + e]; kn_[e] = A.in[10][l * 64 + 8 * j + e]; }
    const float sgn = (j < 4) ? -1.f : 1.f;
    for (int rowb = gw; rowb < MT; rowb += 3 * NGW) {
        v4u rq[3], rk[3]; f32x4 c0[3], c1[3], s0[3], s1[3];
#pragma unroll
        for (int q = 0; q < 3; ++q) { const int row = min(rowb + q * NGW, MT - 1); const bool isl = row < NLAT; const int t = isl ? (row & 2047) : 0;
            const bf16* zr = Z + (size_t)row * INW;
            rq[q] = *(const v4u*)(zr + 8 * lane); rk[q] = *(const v4u*)(zr + O_K + 8 * (lane & 31));
            const f32x4* c4 = (const f32x4*)(rc + t * 32 + 8 * (j & 3)); const f32x4* s4 = (const f32x4*)(rs + t * 32 + 8 * (j & 3));
            c0[q] = c4[0]; c1[q] = c4[1]; s0[q] = s4[0]; s1[q] = s4[1]; }
#pragma unroll
        for (int q = 0; q < 3; ++q) { const int row = rowb + q * NGW; if (row < MT) {
            const bool isl = row < NLAT; const int b = isl ? (row >> 11) : ((row - NLAT) >> 8); const int t = isl ? (row & 2047) : ((row - NLAT) & 255);
            float cs[8], sn[8];
            cs[0] = c0[q].x; cs[1] = c0[q].y; cs[2] = c0[q].z; cs[3] = c0[q].w; cs[4] = c1[q].x; cs[5] = c1[q].y; cs[6] = c1[q].z; cs[7] = c1[q].w;
            sn[0] = s0[q].x; sn[1] = s0[q].y; sn[2] = s0[q].z; sn[3] = s0[q].w; sn[4] = s1[q].x; sn[5] = s1[q].y; sn[6] = s1[q].z; sn[7] = s1[q].w;
            if (!isl) {
#pragma unroll
                for (int e = 0; e < 8; ++e) { cs[e] = 1.f; sn[e] = 0.f; } }
            { float f[8]; unpack8(rq[q], f); float ss = 0.f;
#pragma unroll
                for (int e = 0; e < 8; ++e) ss += f[e] * f[e];
                ss += __shfl_xor(ss, 1); ss += __shfl_xor(ss, 2); ss += __shfl_xor(ss, 4);
                const float rstd = 1.0f / sqrtf(ss * (1.f / 64.f) + EPS);
                float o[8];
#pragma unroll
                for (int e = 0; e < 8; ++e) { const float a = f[e] * rstd * qn_[e]; const float pv = __shfl_xor(a, 4); o[e] = (a * cs[e] + sgn * pv * sn[e]) * attn_body::C2; }
                *(v4u*)(MIX + (size_t)row * 1024 + 8 * lane) = pack8(o); }
            { float f[8]; unpack8(rk[q], f); float ss = 0.f;
#pragma unroll
                for (int e = 0; e < 8; ++e) ss += f[e] * f[e];
                ss += __shfl_xor(ss, 1); ss += __shfl_xor(ss, 2); ss += __shfl_xor(ss, 4);
                const float rstd = 1.0f / sqrtf(ss * (1.f / 64.f) + EPS);
                float o[8];
#pragma unroll
                for (int e = 0; e < 8; ++e) { const float a = f[e] * rstd * kn_[e]; const float pv = __shfl_xor(a, 4); o[e] = a * cs[e] + sgn * pv * sn[e]; }
                const size_t krow = ((size_t)b * NKEY + (isl ? CTXL + t : t)) * KVW;
                if (lane < 16) *(v4u*)(KB + krow + 8 * lane) = pack8(o);
                else if (lane < 32) *(v4u*)(VB + krow + 8 * (lane - 16)) = rk[q]; } } }
    }
}
__device__ __forceinline__ void sgu_item(const Args& A, Frame& F, int l, int ci, int hg, const bf16* Z, bf16* MIX, const float* rssv) {
    relaunder(F);
    const int tid = F.tid, lane = F.lane, wave = F.wave, fr = lane & 15, fq = lane >> 4;
    LAS bf16* vT = (LAS bf16*)F.lds;
    LAS float* U = (LAS float*)(F.lds + 17408);
    LAS bf16* OUT = (LAS bf16*)(F.lds + 17408 + 34816);
    const int row0 = ci * 128;
    const int r = tid >> 2, qd = tid & 3; const bf16* zr = Z + (size_t)(row0 + r) * INW + O_G;
    v4u vg[2], uu[2];
#pragma unroll
    for (int i = 0; i < 2; ++i) { vg[i] = *(const v4u*)(zr + 256 + 64 * hg + 16 * qd + 8 * i); uu[i] = *(const v4u*)(zr + 64 * hg + 16 * qd + 8 * i); }
    const float ssv = rssv[row0 + r];
    const bf16* wsb = (const bf16*)(F.ws + WS_WS) + ((size_t)(l * 4 + hg) * 128 + 16 * wave + fr) * 128 + 8 * fq;
    bf16x8 af[4];
#pragma unroll
    for (int kk = 0; kk < 4; ++kk) af[kk] = *(const bf16x8*)(wsb + 32 * kk);
    const float* gn = A.in[11] + l * 256 + 64 * hg + 16 * qd;
    float gnv[16];
#pragma unroll
    for (int e = 0; e < 16; ++e) gnv[e] = gn[e];
    const float* bs = A.in[13] + (size_t)(l * 4 + hg) * 128 + 16 * wave + 4 * fq;
    float bsv[4];
#pragma unroll
    for (int i = 0; i < 4; ++i) bsv[i] = bs[i];
    {   const float rstd = 1.0f / sqrtf(ssv * (1.f / 256.f) + EPS);
#pragma unroll
        for (int i = 0; i < 2; ++i) { float f[8]; unpack8(vg[i], f);
#pragma unroll
            for (int e = 0; e < 8; ++e) vT[(16 * qd + 8 * i + e) * 136 + r] = (bf16)f2bf(f[e] * rstd * gnv[8 * i + e]); }
#pragma unroll
        for (int i = 0; i < 2; ++i) { float f[8]; unpack8(uu[i], f);
            *(LAS f32x4*)(U + r * 68 + 16 * qd + 8 * i) = (f32x4){f[0], f[1], f[2], f[3]};
            *(LAS f32x4*)(U + r * 68 + 16 * qd + 8 * i + 4) = (f32x4){f[4], f[5], f[6], f[7]}; }
    }
    __syncthreads();
    {   f32x4 acc[4];
#pragma unroll
        for (int n = 0; n < 4; ++n) acc[n] = (f32x4){0.f, 0.f, 0.f, 0.f};
#pragma unroll
        for (int kk = 0; kk < 4; ++kk)
#pragma unroll
            for (int n = 0; n < 4; ++n) { const bf16x8 bfr = *(const LAS bf16x8*)(vT + (16 * n + fr) * 136 + 32 * kk + 8 * fq); acc[n] = __builtin_amdgcn_mfma_f32_16x16x32_bf16(af[kk], bfr, acc[n], 0, 0, 0); }
#pragma unroll
        for (int i = 0; i < 4; ++i) { const int p = 16 * wave + 4 * fq + i;
#pragma unroll
            for (int n = 0; n < 4; ++n) OUT[p * 72 + 16 * n + fr] = (bf16)f2bf(U[p * 68 + 16 * n + fr] * (acc[n][i] + bsv[i])); }
    }
    __syncthreads();
    {   const int p = tid >> 2, c = (tid & 3) * 16;
        const v4u o0 = *(const LAS v4u*)(OUT + p * 72 + c), o1 = *(const LAS v4u*)(OUT + p * 72 + c + 8);
        bf16* dst = MIX + (size_t)(row0 + p) * 1024 + 512 + 64 * hg + c; *(v4u*)dst = o0; *(v4u*)(dst + 8) = o1; }
    __syncthreads();
}
template <int G> __device__ __forceinline__ void pool_item(const Args& A, Frame& F, int l, int ci, const bf16* Z, bf16* MIX) {
    relaunder(F);
    constexpr int W = 2 << G, HALFW = W / 2;
    const int tid = F.tid, lane = F.lane, wave = F.wave, fr = lane & 15, fq = lane >> 4;
    LAS bf16* Dm = (LAS bf16*)F.lds;
    LAS bf16* OUT = (LAS bf16*)(F.lds + 18432);
    const int row0 = ci * 128;
    const int seq0 = ci < 128 ? (ci >> 4) * SEQ : NLAT + ((ci - 128) >> 1) * CTXL, N = ci < 128 ? SEQ : CTXL;
    const bf16* pwb = (const bf16*)(F.ws + WS_PW) + (size_t)(l * 4 + G) * 4096;
    float psc[4];
#pragma unroll
    for (int n = 0; n < 4; ++n) psc[n] = A.in[15][l * 256 + 64 * G + 16 * n + fr];
    {   const int r = tid >> 2, qd = tid & 3; const int t = row0 + r - seq0;
        const bf16* zc = Z + (size_t)seq0 * INW + O_P + 64 * G + 16 * qd;
        float sum[16], pc[16];
#pragma unroll
        for (int e = 0; e < 16; ++e) { sum[e] = 0.f; pc[e] = 0.f; }
        constexpr int BT = W < 8 ? W : 8;
#pragma unroll
        for (int j0 = 0; j0 < W; j0 += BT) {
            v4u ra[BT], rb[BT];
#pragma unroll
            for (int jj = 0; jj < BT; ++jj) { const int tj = t - HALFW + j0 + jj; const int tc = min(max(tj, 0), N - 1); ra[jj] = *(const v4u*)(zc + (size_t)tc * INW); rb[jj] = *(const v4u*)(zc + (size_t)tc * INW + 8); }
#pragma unroll
            for (int jj = 0; jj < BT; ++jj) { const int tj = t - HALFW + j0 + jj; const float wgt = (tj >= 0 && tj < N) ? 1.f : 0.f; float f0[8], f1[8]; unpack8(ra[jj], f0); unpack8(rb[jj], f1);
#pragma unroll
                for (int e = 0; e < 8; ++e) { sum[e] += wgt * f0[e]; sum[8 + e] += wgt * f1[e]; if (j0 + jj == HALFW) { pc[e] = f0[e]; pc[8 + e] = f1[e]; } } }
        }
        const int lo = max(t - HALFW, 0), hi = min(t - HALFW + W, N);
        const float rcnt = 1.0f / (float)(hi - lo);
        float d0[8], d1[8];
#pragma unroll
        for (int e = 0; e < 8; ++e) { d0[e] = sum[e] * rcnt - pc[e]; d1[e] = sum[8 + e] * rcnt - pc[8 + e]; }
        *(LAS v4u*)(Dm + r * 72 + 16 * qd) = pack8(d0); *(LAS v4u*)(Dm + r * 72 + 16 * qd + 8) = pack8(d1);
    }
    bf16x8 bfr[2][4];
#pragma unroll
    for (int kk = 0; kk < 2; ++kk)
#pragma unroll
        for (int n = 0; n < 4; ++n) bfr[kk][n] = *(const bf16x8*)(pwb + (16 * n + fr) * 64 + 32 * kk + 8 * fq);
    __syncthreads();
    {   f32x4 acc[4];
#pragma unroll
        for (int n = 0; n < 4; ++n) acc[n] = (f32x4){0.f, 0.f, 0.f, 0.f};
#pragma unroll
        for (int kk = 0; kk < 2; ++kk) { const bf16x8 a = *(const LAS bf16x8*)(Dm + (16 * wave + fr) * 72 + 32 * kk + 8 * fq);
#pragma unroll
            for (int n = 0; n < 4; ++n) acc[n] = __builtin_amdgcn_mfma_f32_16x16x32_bf16(a, bfr[kk][n], acc[n], 0, 0, 0); }
#pragma unroll
        for (int n = 0; n < 4; ++n)
#pragma unroll
            for (int i = 0; i < 4; ++i) OUT[(16 * wave + 4 * fq + i) * 72 + 16 * n + fr] = (bf16)f2bf(acc[n][i] * psc[n]);
    }
    __syncthreads();
    {   const int p = tid >> 2, c = (tid & 3) * 16;
        const v4u o0 = *(const LAS v4u*)(OUT + p * 72 + c), o1 = *(const LAS v4u*)(OUT + p * 72 + c + 8);
        bf16* dst = MIX + (size_t)(row0 + p) * 1024 + 768 + 64 * G + c; *(v4u*)dst = o0; *(v4u*)(dst + 8) = o1; }
    __syncthreads();
}
__device__ __forceinline__ void prep_phase(const Args& A, Frame& F, int l, const bf16* Z, bf16* MIX, bf16* KB, bf16* VB) {
    prep_qkv(A, F, l, Z, MIX, KB, VB);
    const int NCH = (l + 1 < DEPTH) ? MT / 128 : NLAT / 128;
    unsigned* ctr = (unsigned*)(F.ws + WS_CTL) + 64 * (8 + l);
    volatile LAS unsigned* tk = (volatile LAS unsigned*)(F.lds + MISC_OFF) + 16;
    for (;;) {
        relaunder(F);
        if (F.tid == 0) tk[0] = atomicAdd(ctr, 1u);
        __syncthreads();
        const unsigned it = tk[0];
        __syncthreads();
        if (it >= (unsigned)(NCH * 8)) break;
        const int ord = (int)(it / NCH), ci = (int)(it % NCH);
        const int k = ord == 0 ? 7 : ord == 1 ? 6 : ord < 6 ? ord - 2 : ord == 6 ? 5 : 4;
        if (k < 4) sgu_item(A, F, l, ci, k, Z, MIX, (const float*)(F.ws + WS_RSSV) + (size_t)l * MT);
        else if (k == 4) pool_item<0>(A, F, l, ci, Z, MIX); else if (k == 5) pool_item<1>(A, F, l, ci, Z, MIX); else if (k == 6) pool_item<2>(A, F, l, ci, Z, MIX); else pool_item<3>(A, F, l, ci, Z, MIX);
    }
    bias_phase(F, (const float*)(F.ws + WS_MOD), l);
}

__device__ __forceinline__ void attention_phase(Frame& F, int l, char* lds, bf16* MIX, const bf16* KB, const bf16* VB) {
    const int nunits = (l == 0) ? 576 : 512;
    for (int i = 0;; ++i) {
        const int u = F.vcu + i * F.G; if (u >= nunits) break;
        const attn_body::bf16 *q, *k, *v; int NT;
        if (u < 512) { const int b = (u & 255) >> 5, r = (u & 31) + 32 * (u >> 8), h = r >> 3, qb = r & 7;
            q = (const attn_body::bf16*)MIX + ((size_t)b * SEQ + qb * 256) * 1024 + h * 64; k = (const attn_body::bf16*)KB + (size_t)b * NKEY * KVW + (h >> 2) * 64; v = (const attn_body::bf16*)VB + (size_t)b * NKEY * KVW + (h >> 2) * 64; NT = NKEY / 64; }
        else { const int c = u - 512, b = c >> 3, h = c & 7;
            q = (const attn_body::bf16*)MIX + ((size_t)NLAT + b * CTXL) * 1024 + h * 64; k = (const attn_body::bf16*)KB + (size_t)b * NKEY * KVW + (h >> 2) * 64; v = (const attn_body::bf16*)VB + (size_t)b * NKEY * KVW + (h >> 2) * 64; NT = CTXL / 64; }
        attn_body::attn_unit<8>(q, k, v, (attn_body::bf16*)q, NT, lds);
    }
}

__global__ void __launch_bounds__(NTHR, 2) fwd_megakernel(const Args args) {
    const Args& A = args;
    extern __shared__ __attribute__((aligned(16))) unsigned char lds[];
    Frame F;
    F.lds = (LAS unsigned char*)lds;
    relaunder(F);
    for (int u = threadIdx.x; u < (LDS_BYTES - LDSCTL_OFF) / 4; u += NTHR) ((LAS unsigned*)((LAS unsigned char*)lds + LDSCTL_OFF))[u] = 0u;
    __syncthreads();
    (void)xcd_barrier_post((unsigned*)(args.ws + WS_CTL) + CW_BAR, (volatile LAS unsigned*)((LAS unsigned char*)lds + MISC_OFF) + 8);
#define GRID_BAR() do { __attribute__((address_space(1))) unsigned* bp_ = (__attribute__((address_space(1))) unsigned*)((unsigned*)(args.ws + WS_CTL) + CW_BAR); asm volatile("" : "+s"(bp_)); XcdBarrier b_; b_.bar = (unsigned*)bp_; b_.x = xb_xcc_id(); b_.st = (volatile LAS unsigned*)((LAS unsigned char*)lds + MISC_OFF) + 8; xcd_barrier(b_); } while (0)
    F.G = gridDim.x; { const int bx = blockIdx.x; F.vcu = (F.G % 8 == 0) ? (bx % 8) * (F.G / 8) + bx / 8 : bx; }
    F.out = args.out; F.ws = args.ws;
#define GASP __attribute__((address_space(1)))
#define WSL() ({ GASP unsigned char* w_ = (GASP unsigned char*)args.ws; asm volatile("" : "+s"(w_)); (unsigned char*)w_; })
#define P_H ((bf16*)(WSL() + WS_H))
#define P_Z ((bf16*)(WSL() + WS_Z))
#define P_MIX ((bf16*)(WSL() + WS_MIX))
#define P_KB ((bf16*)(WSL() + WS_KB))
#define P_VB ((bf16*)(WSL() + WS_VB))
#define P_ACT ((bf16*)(WSL() + WS_ACT))
#define P_CTXRES ((float*)(WSL() + WS_CTXRES))
#define P_XRES ({ GASP float* o_ = (GASP float*)args.out; asm volatile("" : "+s"(o_)); (float*)o_; })
#define P_MOD ((const float*)(WSL() + WS_MOD))
#define P_RSS ((float*)(WSL() + WS_RSS))
#define P_BIASIN ((const float*)(WSL() + WS_BIASIN))
#define P_BIASGU ((const float*)(WSL() + WS_BIAS) + (size_t)DEPTH * 9 * INW)
#define P_SLABS ((float*)(WSL() + WS_SLAB))
#define P_XH ((unsigned short*)(WSL() + WS_XH))

    p0_prologue(args, F);
    GRID_BAR();
    {
        const int Mrows = (0 == 0) ? MT : NLAT;
        {   pg8::Gemm g{P_H, (const bf16*)(WSL() + WS_WIN) + (size_t)0 * INW * 1024, MT, INW, 1024}; pg8::StaticOrder S; S.init(MT, INW, F.G, (int)blockIdx.x);
            pg8::EpiStoreBf16 E{P_Z, INW, P_RSS + (0 == 0 ? 3 : 1) * MT, P_BIASIN + (size_t)0 * 9 * INW, INW, F.lds, (float*)(WSL() + WS_RSSV) + (size_t)0 * MT};
            pg8::gemm_phase<pg8::EpiStoreBf16, pg8::StaticOrder, true, true>(F.lds, g, S, E); }
        tail_transposes(args, F, 1, (MT / 256) * (INW / 256));
        GRID_BAR();
        prep_phase(args, F, 0, P_Z, P_MIX, P_KB, P_VB);
        GRID_BAR();
        attention_phase(F, 0, (char*)lds, P_MIX, P_KB, P_VB);
        GRID_BAR();
        {   pg8::Gemm g{P_MIX, (const bf16*)(WSL() + WS_WOUT) + (size_t)0 * 1024 * 1024, Mrows, 1024, 1024};
            pg8::EpiResid<true> E{A.in[0], P_XH, (P_MOD + (size_t)0 * 9 * MODW) + 2048, A.in[7] + 0 * DMODEL, (P_MOD + (size_t)0 * 9 * MODW) + 4096, P_H, P_RSS + (0 == 0 ? 0 : 2) * MT};
            if (0 == 0) { pg8::SliceOrder S2; S2.init(1024, KSPLIT, F.G, (int)blockIdx.x); pg8::EpiSlab E2{P_SLABS}; pg8::gemm_phase<pg8::EpiSlab, pg8::SliceOrder, true, true>(F.lds, g, S2, E2); }
            pg8::StaticOrder S; S.init(NLAT, 1024, F.G, (int)blockIdx.x); pg8::gemm_phase<pg8::EpiResid<true>, pg8::StaticOrder, false, true>(F.lds, g, S, E); }
        GRID_BAR();
        if (0 == 0) { ctx_combine_phase(F, P_SLABS, ((0 == 0) ? A.in[2] : (const float*)P_CTXRES), P_CTXRES, (P_MOD + (size_t)0 * 9 * MODW) + 2048, A.in[7] + 0 * DMODEL, (P_MOD + (size_t)0 * 9 * MODW) + 4096, P_H, P_RSS + 0 * MT); GRID_BAR(); }
        {   pg8::Gemm g{P_H, (const bf16*)(WSL() + WS_WGU) + (size_t)0 * 2 * FF * 1024, Mrows, 2 * FF, 1024}; pg8::CtxFirstOrder S; S.init(2 * FF, F.G, (int)blockIdx.x);
            unsigned* ctx_done = (unsigned*)(WSL() + WS_CTL) + 64 * 11;
            pg8::EpiSwiGLU E{P_ACT, FF, P_RSS + (0 == 0 ? 0 : 2) * MT, P_BIASGU + (size_t)0 * 9 * 2 * FF, 2 * FF, F.lds, ctx_done};
            pg8::gemm_phase<pg8::EpiSwiGLU, pg8::CtxFirstOrder, true, true>(F.lds, g, S, E);
            {   const int nwg = (MT / 256) * (2 * FF / 256), G = F.G, rounds = (nwg + G - 1) / G; int first_idle = nwg - G * (rounds - 1); if (first_idle >= G) first_idle = 0;
                if ((int)blockIdx.x >= first_idle) {
                    if (threadIdx.x == 0) { unsigned sp = 0;
                        while (__hip_atomic_load(ctx_done, __ATOMIC_RELAXED, __HIP_MEMORY_SCOPE_AGENT) < 8u * (2 * FF / 256)) { __builtin_amdgcn_s_sleep(2); if (++sp > (1u << 20)) break; }
                        __builtin_amdgcn_fence(__ATOMIC_ACQUIRE, "agent"); asm volatile("s_waitcnt vmcnt(0)" ::: "memory"); }
                    __syncthreads();
                    pg8::Gemm g2{P_ACT, (const bf16*)(WSL() + WS_WDN) + (size_t)0 * 1024 * FF, Mrows, 1024, FF};
                    pg8::SliceOrder S2; S2.init(FF, KSPLIT, G - first_idle, (int)blockIdx.x - first_idle); pg8::EpiSlab E2{P_SLABS};
                    pg8::gemm_phase<pg8::EpiSlab, pg8::SliceOrder, true, true>(F.lds, g2, S2, E2); } } }
        GRID_BAR();
        ctx_combine_phase(F, P_SLABS, P_CTXRES, P_CTXRES, (P_MOD + (size_t)0 * 9 * MODW) + 5120, A.in[6] + 1 * DMODEL, P_MOD + (size_t)1 * 9 * MODW + 1024, P_H, P_RSS + 1 * MT);
        {   pg8::Gemm g{P_ACT, (const bf16*)(WSL() + WS_WDN) + (size_t)0 * 1024 * FF, Mrows, 1024, FF}; pg8::StaticOrder S; S.init(NLAT, 1024, F.G, (int)blockIdx.x);
            const int nl = (0 + 1 < DEPTH) ? 0 + 1 : 0;
            pg8::EpiResid<false> E{P_XH, P_XH, (P_MOD + (size_t)0 * 9 * MODW) + 5120, A.in[6] + nl * DMODEL, P_MOD + (size_t)nl * 9 * MODW + 1024, P_H, P_RSS + 1 * MT};
            pg8::gemm_phase<pg8::EpiResid<false>, pg8::StaticOrder, false, true>(F.lds, g, S, E); }
        GRID_BAR();
    }
    {
        const int Mrows = (1 == 0) ? MT : NLAT;
        {   pg8::Gemm g{P_H, (const bf16*)(WSL() + WS_WIN) + (size_t)1 * INW * 1024, MT, INW, 1024}; pg8::StaticOrder S; S.init(MT, INW, F.G, (int)blockIdx.x);
            pg8::EpiStoreBf16 E{P_Z, INW, P_RSS + (1 == 0 ? 3 : 1) * MT, P_BIASIN + (size_t)1 * 9 * INW, INW, F.lds, (float*)(WSL() + WS_RSSV) + (size_t)1 * MT};
            pg8::gemm_phase<pg8::EpiStoreBf16, pg8::StaticOrder, true, true>(F.lds, g, S, E); }
        tail_transposes(args, F, 2, (MT / 256) * (INW / 256));
        GRID_BAR();
        prep_phase(args, F, 1, P_Z, P_MIX, P_KB, P_VB);
        GRID_BAR();
        attention_phase(F, 1, (char*)lds, P_MIX, P_KB, P_VB);
        GRID_BAR();
        {   pg8::Gemm g{P_MIX, (const bf16*)(WSL() + WS_WOUT) + (size_t)1 * 1024 * 1024, Mrows, 1024, 1024};
            pg8::EpiResid<false> E{P_XH, P_XH, (P_MOD + (size_t)1 * 9 * MODW) + 2048, A.in[7] + 1 * DMODEL, (P_MOD + (size_t)1 * 9 * MODW) + 4096, P_H, P_RSS + (1 == 0 ? 0 : 2) * MT};
            pg8::StaticOrder S; S.init(NLAT, 1024, F.G, (int)blockIdx.x); pg8::gemm_phase<pg8::EpiResid<false>, pg8::StaticOrder, false, true>(F.lds, g, S, E);
            if (1 == 0) { pg8::SliceOrder S2; S2.init(1024, KSPLIT, F.G, (int)blockIdx.x); pg8::EpiSlab E2{P_SLABS}; pg8::gemm_phase<pg8::EpiSlab, pg8::SliceOrder, true, true>(F.lds, g, S2, E2); } }
        GRID_BAR();
        if (1 == 0) { ctx_combine_phase(F, P_SLABS, ((1 == 0) ? A.in[2] : (const float*)P_CTXRES), P_CTXRES, (P_MOD + (size_t)1 * 9 * MODW) + 2048, A.in[7] + 1 * DMODEL, (P_MOD + (size_t)1 * 9 * MODW) + 4096, P_H, P_RSS + 0 * MT); GRID_BAR(); }
        {   pg8::Gemm g{P_H, (const bf16*)(WSL() + WS_WGU) + (size_t)1 * 2 * FF * 1024, Mrows, 2 * FF, 1024}; pg8::StaticOrder S; S.init(Mrows, 2 * FF, F.G, (int)blockIdx.x);
            pg8::EpiSwiGLU E{P_ACT, FF, P_RSS + (1 == 0 ? 0 : 2) * MT, P_BIASGU + (size_t)1 * 9 * 2 * FF, 2 * FF, F.lds, nullptr};
            pg8::gemm_phase<pg8::EpiSwiGLU, pg8::StaticOrder, true, true>(F.lds, g, S, E); }
        GRID_BAR();
        {   pg8::Gemm g{P_ACT, (const bf16*)(WSL() + WS_WDN) + (size_t)1 * 1024 * FF, Mrows, 1024, FF}; pg8::StaticOrder S; S.init(NLAT, 1024, F.G, (int)blockIdx.x);
            const int nl = (1 + 1 < DEPTH) ? 1 + 1 : 1;
            if (F.G == 256) {
                pg8::EpiResidFinal E{P_XH, P_XRES, (P_MOD + (size_t)1 * 9 * MODW) + 5120, A.in[20], P_RSS + 4 * MT, (unsigned*)(WSL() + WS_CTL) + CW_PANEL, (LAS unsigned*)(F.lds + MISC_OFF) + 20};
                pg8::gemm_phase<pg8::EpiResidFinal, pg8::StaticOrder, true, true>(F.lds, g, S, E);
            } else {
            pg8::EpiResid<false> E{P_XH, P_XH, (P_MOD + (size_t)1 * 9 * MODW) + 5120, A.in[6] + nl * DMODEL, P_MOD + (size_t)nl * 9 * MODW + 1024, P_H, P_RSS + 1 * MT};
            pg8::gemm_phase<pg8::EpiResid<false>, pg8::StaticOrder, false, true>(F.lds, g, S, E); }
            if (1 == 0) { pg8::SliceOrder S2; S2.init(FF, KSPLIT, F.G, (int)blockIdx.x); pg8::EpiSlab E2{P_SLABS}; pg8::gemm_phase<pg8::EpiSlab, pg8::SliceOrder, true, true>(F.lds, g, S2, E2); } }
        if (F.G != 256) GRID_BAR();
        if (1 == 0) { ctx_combine_phase(F, P_SLABS, P_CTXRES, P_CTXRES, (P_MOD + (size_t)1 * 9 * MODW) + 5120, A.in[6] + 1 * DMODEL, P_MOD + (size_t)1 * 9 * MODW + 1024, P_H, P_RSS + 1 * MT); GRID_BAR(); }
    }
    if (F.G != 256) final_norm_phase(F, P_XH, P_XRES, A.in[20]);
}

extern "C" void kernel_launch(void* const* d_in, const int* in_sizes, int n_in, void* d_out, int out_size, void* d_ws, size_t ws_size, hipStream_t stream) {
    static int grid = 0;
    if (grid == 0) {
        if (n_in != 21 || out_size != NLAT * DMODEL || ws_size < 256 * MiB) { fprintf(stderr, "kernel_launch: unexpected shapes (n_in %d out %d ws %zu)\n", n_in, out_size, ws_size); grid = -1; return; }
        int dev = 0, cus = 0, per_cu = 0;
        hipGetDevice(&dev); hipDeviceGetAttribute(&cus, hipDeviceAttributeMultiprocessorCount, dev);
        if (hipFuncSetAttribute((const void*)fwd_megakernel, hipFuncAttributeMaxDynamicSharedMemorySize, LDS_BYTES) != hipSuccess) { fprintf(stderr, "kernel_launch: hipFuncSetAttribute failed\n"); grid = -1; return; }
        if (hipOccupancyMaxActiveBlocksPerMultiprocessor(&per_cu, (const void*)fwd_megakernel, NTHR, LDS_BYTES) != hipSuccess || per_cu < 1) { fprintf(stderr, "kernel_launch: occupancy query says %d blocks per CU\n", per_cu); (void)hipGetLastError(); grid = -1; return; }
        grid = cus * 1;
        fprintf(stderr, "kernel_launch: grid %d (cus %d, per_cu %d)\n", grid, cus, per_cu);
    }
    if (grid < 0) return;
    (void)hipMemsetAsync((char*)d_ws + WS_CTL, 0, CTL_ZERO_BYTES, stream);
    Args a{};
    for (int i = 0; i < 21; ++i) a.in[i] = (const float*)d_in[i];
    a.out = (float*)d_out; a.ws = (unsigned char*)d_ws; a.pad = 0ull;
    void* kargs[] = {&a};
    hipError_t e = hipLaunchCooperativeKernel((const void*)fwd_megakernel, dim3(grid), dim3(NTHR), kargs, LDS_BYTES, stream);
    if (e != hipSuccess) fprintf(stderr, "kernel_launch: cooperative launch failed: %s (grid %d)\n", hipGetErrorString(e), grid);
}
```

```cpp
#include <hip/hip_runtime.h>
#include <hip/hip_bf16.h>
#include <cstdio>
#include <cstdint>
#include <cmath>
namespace pg8 {
#define PG8_LAS __attribute__((address_space(3)))
typedef unsigned short bf16_t;
typedef short bf16x8 __attribute__((ext_vector_type(8)));
typedef float f32x4 __attribute__((ext_vector_type(4)));
typedef unsigned u32x4 __attribute__((ext_vector_type(4)));
constexpr int BM = 256, BK = 64, HALF = 128, HTB = HALF * BK * 2  , STAGE_BYTES = 8 * HTB, NXCD = 8, WGM = 8;

__host__ __device__ __forceinline__ int lds_byte(int r, int c) { const int st = (r >> 4) * 2 + (c >> 5), rr = r & 15, cc = c & 31, ob = rr * 64 + cc * 2; return st * 1024 + (ob ^ (((ob >> 9) & 1) << 5)); }
__host__ __device__ __forceinline__ void stage_rc(int b, int& R, int& C) { const int st = b / 1024, sb = b % 1024, swz = sb ^ (((sb >> 9) & 1) << 5); R = (st >> 1) * 16 + swz / 64; C = (st & 1) * 32 + (swz % 64) / 2; }
__host__ __device__ __forceinline__ int perm32(int rho) { const int n = rho >> 4, i = rho & 15; return 8 * (i >> 2) + 4 * n + (i & 3); }

struct Unit { int pm, pn, k0b, nt, slice; };
struct Gemm { const bf16_t* A; const bf16_t* Bt; int M, N, K; };

struct StaticOrder {
    static constexpr bool SPLIT = false;
    int nM, nN, nwg, G, c;
    __host__ __device__ void init(int M, int N, int G_, int c_) { nM = M / BM; nN = N / BM; nwg = nM * nN; G = G_; c = c_; }
    __host__ __device__ bool next(int i, Unit& u) const { const long L = (long)i * G + c; if (L >= nwg) return false; map((int)L, u); return true; }
    __host__ __device__ void map(int L, Unit& u) const {
        int wgid = L; { const int q = nwg / NXCD, r = nwg % NXCD, xcd = wgid % NXCD, off = wgid / NXCD; wgid = (xcd < r ? xcd * (q + 1) : r * (q + 1) + (xcd - r) * q) + off; }
        const int nig = WGM * nN, gid = wgid / nig, fm = gid * WGM, gsz = (nM - fm) < WGM ? (nM - fm) : WGM;
        u.pm = fm + ((wgid % nig) % gsz); u.pn = (wgid % nig) / gsz;
    }
    __device__ __forceinline__ void a_ready(const Unit&) const {}
    __device__ __forceinline__ void done(const Unit&) const {}
};

__device__ __forceinline__ unsigned cvt_pk_bf16(float lo, float hi) { unsigned r; asm volatile("v_cvt_pk_bf16_f32 %0, %1, %2" : "=v"(r) : "v"(lo), "v"(hi)); return r; }
typedef float f32x2 __attribute__((ext_vector_type(2)));
typedef unsigned u32x2 __attribute__((ext_vector_type(2)));
constexpr int XOFF = 132096;
struct EpiStoreBf16 {
    static constexpr bool PERM = true, AFTER_DRAIN = false, PREFETCH = true;
    bf16_t* O; int ldc; const float* rss; const float* bias; int ldb; PG8_LAS unsigned char* lds; float* rssv;
    __device__ __forceinline__ void prefetch(const Unit& u, int ui, int tid, int wid) const {
        const float* src = (wid < 4) ? rss + (size_t)u.pm * BM + tid : bias + (size_t)(u.pm < 64 ? (u.pm >> 3) : 8) * ldb + (size_t)u.pn * BM + (tid - 256);
        __builtin_amdgcn_global_load_lds((const unsigned*)src, (PG8_LAS unsigned*)(lds + XOFF + (ui & 1) * 2048 + wid * 256), 4, 0, 0);
    }
    static __device__ __forceinline__ float gelu1(float x) { const float y = 0.7978845608028654f * (x + 0.044715f * x * x * x); return x * __builtin_amdgcn_rcpf(1.0f + __builtin_amdgcn_exp2f(y * -2.8853900817779268f)); }
    __device__ __forceinline__ void operator()(const f32x4 (&acc)[2][2][4][2], const Unit& u, int wr, int wc, int fr, int fq, int ui) const {
        const int row0 = u.pm * BM + wr * 64 + fr, col0 = u.pn * BM + wc * 32 + 8 * fq;
        const bool act = (u.pn == 3) | (u.pn == 4);
        const PG8_LAS float* xs = (const PG8_LAS float*)(lds + XOFF + (ui & 1) * 2048);
        f32x4 bv[2][2];
#pragma unroll
        for (int bj = 0; bj < 2; ++bj)
#pragma unroll
            for (int n = 0; n < 2; ++n) bv[bj][n] = *(const PG8_LAS f32x4*)(xs + 256 + wc * 32 + 8 * fq + bj * HALF + 4 * n);
#pragma unroll
        for (int ai = 0; ai < 2; ++ai)
#pragma unroll
            for (int m = 0; m < 4; ++m) { const int rl = wr * 64 + fr + ai * HALF + m * 16; bf16_t* rowp = O + (size_t)(u.pm * BM + rl) * ldc + col0;
                const float rs = 1.0f / sqrtf(xs[rl] * (1.0f / 1024.0f) + 1e-6f);
                float rsq = 0.f;
#pragma unroll
                for (int bj = 0; bj < 2; ++bj) { f32x4 v0 = acc[ai][bj][m][0] * rs + bv[bj][0], v1 = acc[ai][bj][m][1] * rs + bv[bj][1];
                    if (act) {
#pragma unroll
                        for (int e = 0; e < 4; ++e) { v0[e] = gelu1(v0[e]); v1[e] = gelu1(v1[e]); }
                        rsq += ((v0[0] * v0[0] + v0[1] * v0[1]) + (v0[2] * v0[2] + v0[3] * v0[3])) + ((v1[0] * v1[0] + v1[1] * v1[1]) + (v1[2] * v1[2] + v1[3] * v1[3])); }
                    u32x4 w; w.x = cvt_pk_bf16(v0[0], v0[1]); w.y = cvt_pk_bf16(v0[2], v0[3]); w.z = cvt_pk_bf16(v1[0], v1[1]); w.w = cvt_pk_bf16(v1[2], v1[3]);
                    *(u32x4*)(rowp + bj * HALF) = w; }
                if (u.pn == 4) { rsq += __shfl_xor(rsq, 16); rsq += __shfl_xor(rsq, 32); if (fq == 0) atomicAdd(rssv + (u.pm * BM + rl), rsq); } }
    }
};
__device__ __forceinline__ float silu_mul(float g, float u) { const float e = __builtin_amdgcn_exp2f(g * -1.4426950408889634f); return g * __builtin_amdgcn_rcpf(1.0f + e) * u; }
struct EpiSwiGLU {
    static constexpr bool PERM = true, AFTER_DRAIN = false, PREFETCH = true;
    bf16_t* O; int ldc; const float* rss; const float* bias; int ldb; PG8_LAS unsigned char* lds;
    unsigned* ctx_done;
    __device__ __forceinline__ void prefetch(const Unit& u, int ui, int tid, int wid) const {
        const float* src = (wid < 4) ? rss + (size_t)u.pm * BM + tid : bias + (size_t)(u.pm < 64 ? (u.pm >> 3) : 8) * ldb + (size_t)u.pn * BM + (tid - 256);
        __builtin_amdgcn_global_load_lds((const unsigned*)src, (PG8_LAS unsigned*)(lds + XOFF + (ui & 1) * 2048 + wid * 256), 4, 0, 0);
    }
    __device__ __forceinline__ void operator()(const f32x4 (&acc)[2][2][4][2], const Unit& u, int wr, int wc, int fr, int fq, int ui) const {
        const int col0 = u.pn * HALF + wc * 32 + 8 * fq;
        const PG8_LAS float* xs = (const PG8_LAS float*)(lds + XOFF + (ui & 1) * 2048);
        const PG8_LAS float* bp = xs + 256 + wc * 32 + 8 * fq;
        const f32x4 bg0 = *(const PG8_LAS f32x4*)(bp), bg1 = *(const PG8_LAS f32x4*)(bp + 4), bu0 = *(const PG8_LAS f32x4*)(bp + HALF), bu1 = *(const PG8_LAS f32x4*)(bp + HALF + 4);
#pragma unroll
        for (int ai = 0; ai < 2; ++ai)
#pragma unroll
            for (int m = 0; m < 4; ++m) { const int rl = wr * 64 + fr + ai * HALF + m * 16; bf16_t* rowp = O + (size_t)(u.pm * BM + rl) * ldc + col0;
                const float rs = 1.0f / sqrtf(xs[rl] * (1.0f / 1024.0f) + 1e-6f);
                const f32x4 g0 = acc[ai][0][m][0] * rs + bg0, g1 = acc[ai][0][m][1] * rs + bg1, u0 = acc[ai][1][m][0] * rs + bu0, u1 = acc[ai][1][m][1] * rs + bu1;
                u32x4 w; w.x = cvt_pk_bf16(silu_mul(g0[0], u0[0]), silu_mul(g0[1], u0[1])); w.y = cvt_pk_bf16(silu_mul(g0[2], u0[2]), silu_mul(g0[3], u0[3]));
                w.z = cvt_pk_bf16(silu_mul(g1[0], u1[0]), silu_mul(g1[1], u1[1])); w.w = cvt_pk_bf16(silu_mul(g1[2], u1[2]), silu_mul(g1[3], u1[3]));
                *(u32x4*)rowp = w; }
        if (ctx_done != nullptr && u.pm >= 64) {
            asm volatile("s_waitcnt vmcnt(0)" ::: "memory"); __builtin_amdgcn_s_barrier(); asm volatile("" ::: "memory");
            if (threadIdx.x == 0) { __builtin_amdgcn_fence(__ATOMIC_RELEASE, "agent"); asm volatile("s_waitcnt vmcnt(0)" ::: "memory");
                __hip_atomic_fetch_add(ctx_done, 1u, __ATOMIC_RELAXED, __HIP_MEMORY_SCOPE_AGENT); } }
    }
};
struct CtxFirstOrder {
    static constexpr bool SPLIT = false;
    StaticOrder so;
    __host__ __device__ void init(int N, int G_, int c_) { so.init(16384, N, G_, c_); }
    __host__ __device__ int nctx() const { return 8 * so.nN; }
    __host__ __device__ bool next(int i, Unit& u) const {
        const long L = (long)i * so.G + so.c; const int nc = 8 * so.nN;
        if (L < nc) { u.pm = 64 + (int)(L & 7); u.pn = (int)(L >> 3); return true; }
        if (L - nc >= so.nwg) return false;
        so.map((int)(L - nc), u); return true;
    }
    __device__ __forceinline__ void a_ready(const Unit&) const {}
    __device__ __forceinline__ void done(const Unit&) const {}
};
struct SliceOrder {
    static constexpr bool SPLIT = true;
    int G, c, S, ntf;
    __host__ __device__ void init(int K, int S_, int G_, int c_) { G = G_; c = c_; S = S_; ntf = K / BK; }
    __host__ __device__ bool next(int i, Unit& u) const {
        const long L = (long)i * G + c; if (L >= 32 * S) return false;
        const int s = (int)L, tile = s / S, sl = s % S, P = ntf / 2, base = P / S, rem = P % S;
        u.pm = 64 + (tile & 7); u.pn = tile >> 3; u.nt = 2 * (base + (sl < rem ? 1 : 0)); u.k0b = (sl * base + (sl < rem ? sl : rem)) * 256; u.slice = s; return true;
    }
    __device__ __forceinline__ void a_ready(const Unit&) const {}
    __device__ __forceinline__ void done(const Unit&) const {}
};
struct EpiSlab {
    static constexpr bool PERM = true, AFTER_DRAIN = false, PREFETCH = false;
    float* slabs;
    __device__ __forceinline__ void operator()(const f32x4 (&acc)[2][2][4][2], const Unit& u, int wr, int wc, int fr, int fq) const {
        float* sp_ = slabs + (size_t)u.slice * 65536 + wc * 32 + 8 * fq + (size_t)(wr * 64 + fr) * 256;
#pragma unroll
        for (int ai = 0; ai < 2; ++ai)
#pragma unroll
            for (int m = 0; m < 4; ++m) { float* q = sp_ + (ai * HALF + m * 16) * 256;
                *(f32x4*)q = acc[ai][0][m][0]; *(f32x4*)(q + 4) = acc[ai][0][m][1]; *(f32x4*)(q + HALF) = acc[ai][1][m][0]; *(f32x4*)(q + HALF + 4) = acc[ai][1][m][1]; }
    }
};
typedef _Float16 f16x8 __attribute__((ext_vector_type(8)));
typedef float f32x8 __attribute__((ext_vector_type(8)));
__device__ __forceinline__ u32x4 pack_h8(const f32x4 a, const f32x4 b) { const f32x8 v = {a[0], a[1], a[2], a[3], b[0], b[1], b[2], b[3]}; return __builtin_bit_cast(u32x4, __builtin_convertvector(v, f16x8)); }
__device__ __forceinline__ void unpack_h8(const u32x4 w, f32x4& a, f32x4& b) { const f32x8 v = __builtin_convertvector(__builtin_bit_cast(f16x8, w), f32x8); a = (f32x4){v[0], v[1], v[2], v[3]}; b = (f32x4){v[4], v[5], v[6], v[7]}; }
template <bool BASEF32> struct EpiResid {
    static constexpr bool PERM = true, AFTER_DRAIN = false, PREFETCH = false;
    static constexpr int LDC = 1024, MODLD = 6144;
    const void* base; unsigned short* xh; const float* gate;
    const float* gn; const float* scn; bf16_t* H; float* rss;
    __device__ __forceinline__ void operator()(const f32x4 (&acc)[2][2][4][2], const Unit& u, int wr, int wc, int fr_in, int fq) const {
        int fr = fr_in; asm volatile("" : "+v"(fr));
        const int b = u.pm >> 3; const size_t t0 = (size_t)u.pm * BM * LDC;
        const float* bpf = (const float*)base + t0; const unsigned short* bph = (const unsigned short*)base + t0; unsigned short* op = xh + t0;
        const float* gp = gate + (size_t)b * MODLD; const float* sp = scn + (size_t)b * MODLD;
        const int col0 = u.pn * BM + wc * 32 + 8 * fq;
        float rsum[2][4];
#pragma unroll
        for (int ai = 0; ai < 2; ++ai)
#pragma unroll
            for (int m = 0; m < 4; ++m) rsum[ai][m] = 0.f;
#pragma unroll
        for (int bj = 0; bj < 2; ++bj) { const int cc = col0 + bj * HALF;
            const f32x4 gv0 = *(const f32x4*)(gp + cc), gv1 = *(const f32x4*)(gp + cc + 4);
            const f32x4 Gn0 = *(const f32x4*)(gn + cc) * (*(const f32x4*)(sp + cc) + 1.0f), Gn1 = *(const f32x4*)(gn + cc + 4) * (*(const f32x4*)(sp + cc + 4) + 1.0f);
#pragma unroll
            for (int am = 0; am < 4; ++am) { const int ai = am >> 1, mb = (am & 1) * 2; f32x4 b0[4], b1[4];
#pragma unroll
                for (int m = mb; m < mb + 2; ++m) { const size_t off = (size_t)(ai * HALF + wr * 64 + m * 16 + fr) * LDC + cc;
                    if constexpr (BASEF32) { b0[m] = *(const f32x4*)(bpf + off); b1[m] = *(const f32x4*)(bpf + off + 4); }
                    else { const u32x4 w = *(const u32x4*)(bph + off); unpack_h8(w, b0[m], b1[m]); } }
#pragma unroll
                for (int m = mb; m < mb + 2; ++m) { const int rl = ai * HALF + wr * 64 + m * 16 + fr; const size_t off = (size_t)rl * LDC + cc;
                    const f32x4 x0 = b0[m] + gv0 * acc[ai][bj][m][0], x1 = b1[m] + gv1 * acc[ai][bj][m][1]; *(u32x4*)(op + off) = pack_h8(x0, x1);
                    rsum[ai][m] += ((x0[0] * x0[0] + x0[1] * x0[1]) + (x0[2] * x0[2] + x0[3] * x0[3])) + ((x1[0] * x1[0] + x1[1] * x1[1]) + (x1[2] * x1[2] + x1[3] * x1[3]));
                    const f32x4 a0 = x0 * Gn0, a1 = x1 * Gn1;
                    u32x4 w; w.x = cvt_pk_bf16(a0[0], a0[1]); w.y = cvt_pk_bf16(a0[2], a0[3]); w.z = cvt_pk_bf16(a1[0], a1[1]); w.w = cvt_pk_bf16(a1[2], a1[3]);
                    *(u32x4*)(H + (size_t)(u.pm * BM + rl) * LDC + cc) = w; } } }
        {
#pragma unroll
            for (int ai = 0; ai < 2; ++ai)
#pragma unroll
                for (int m = 0; m < 4; ++m) { float sv = rsum[ai][m]; sv += __shfl_xor(sv, 16); sv += __shfl_xor(sv, 32);
                    if (fq == 0) atomicAdd(rss + (u.pm * BM + ai * HALF + wr * 64 + m * 16 + fr), sv); } }
    }
};

struct EpiResidFinal {
    static constexpr bool PERM = true, AFTER_DRAIN = false, PREFETCH = false;
    static constexpr int LDC = 1024, MODLD = 6144;
    const unsigned short* base; float* out; const float* gate; const float* fnorm; float* rss; unsigned* cnt; PG8_LAS unsigned* flag;
    __device__ __forceinline__ void operator()(f32x4 (&acc)[2][2][4][2], const Unit& u, int wr, int wc, int fr_in, int fq) const {
        int fr = fr_in; asm volatile("" : "+v"(fr));
        const int b = u.pm >> 3;
        const unsigned short* bp = base + (size_t)u.pm * BM * LDC; float* op = out + (size_t)u.pm * BM * LDC;
        const float* gp = gate + (size_t)b * MODLD;
        const int col0 = u.pn * BM + wc * 32 + 8 * fq;
        float rsum[2][4];
#pragma unroll
        for (int ai = 0; ai < 2; ++ai)
#pragma unroll
            for (int m = 0; m < 4; ++m) rsum[ai][m] = 0.f;
#pragma unroll
        for (int bj = 0; bj < 2; ++bj) { const int cc = col0 + bj * HALF;
            const f32x4 gv0 = *(const f32x4*)(gp + cc), gv1 = *(const f32x4*)(gp + cc + 4);
#pragma unroll
            for (int am = 0; am < 4; ++am) { const int ai = am >> 1, mb = (am & 1) * 2; f32x4 b0[4], b1[4];
#pragma unroll
                for (int m = mb; m < mb + 2; ++m) { const u32x4 w = *(const u32x4*)(bp + (size_t)(ai * HALF + wr * 64 + m * 16 + fr) * LDC + cc); unpack_h8(w, b0[m], b1[m]); }
#pragma unroll
                for (int m = mb; m < mb + 2; ++m) { const f32x4 x0 = b0[m] + gv0 * acc[ai][bj][m][0], x1 = b1[m] + gv1 * acc[ai][bj][m][1]; acc[ai][bj][m][0] = x0; acc[ai][bj][m][1] = x1;
                    rsum[ai][m] += ((x0[0] * x0[0] + x0[1] * x0[1]) + (x0[2] * x0[2] + x0[3] * x0[3])) + ((x1[0] * x1[0] + x1[1] * x1[1]) + (x1[2] * x1[2] + x1[3] * x1[3])); }
                asm volatile("" : "+v"(fr) : "v"(rsum[ai][mb + 1]) : "memory"); } }
#pragma unroll
        for (int ai = 0; ai < 2; ++ai)
#pragma unroll
            for (int m = 0; m < 4; ++m) { float sv = rsum[ai][m]; sv += __shfl_xor(sv, 16); sv += __shfl_xor(sv, 32);
                if (fq == 0) atomicAdd(rss + (u.pm * BM + ai * HALF + wr * 64 + m * 16 + fr), sv); }
        asm volatile("s_waitcnt vmcnt(0)" ::: "memory");
        __builtin_amdgcn_s_barrier(); asm volatile("" ::: "memory");
        if (threadIdx.x == 0) {
            __builtin_amdgcn_fence(__ATOMIC_RELEASE, "agent"); asm volatile("s_waitcnt vmcnt(0)" ::: "memory");
            __hip_atomic_fetch_add(cnt + 64 * u.pm, 1u, __ATOMIC_RELAXED, __HIP_MEMORY_SCOPE_AGENT);
            unsigned sp = 0;
            while (__hip_atomic_load(cnt + 64 * u.pm, __ATOMIC_RELAXED, __HIP_MEMORY_SCOPE_AGENT) < 4u) { __builtin_amdgcn_s_sleep(2); if (++sp > (1u << 20)) break; }
            __builtin_amdgcn_fence(__ATOMIC_ACQUIRE, "agent"); asm volatile("s_waitcnt vmcnt(0)" ::: "memory");
            flag[0] = 1u;
        }
        asm volatile("s_waitcnt vmcnt(0) lgkmcnt(0)" ::: "memory");
        __builtin_amdgcn_s_barrier(); asm volatile("" ::: "memory");
        asm volatile("" : "+v"(fr));
        float rs[2][4];
#pragma unroll
        for (int ai = 0; ai < 2; ++ai)
#pragma unroll
            for (int m = 0; m < 4; ++m) { float* q = rss + (u.pm * BM + ai * HALF + wr * 64 + m * 16 + fr); asm volatile("" : "+v"(q)); rs[ai][m] = 1.0f / sqrtf(__hip_atomic_load(q, __ATOMIC_RELAXED, __HIP_MEMORY_SCOPE_AGENT) * (1.0f / 1024.0f) + 1e-6f); }
#pragma unroll
        for (int bj = 0; bj < 2; ++bj) { const int cc = col0 + bj * HALF; const f32x4 f0 = *(const f32x4*)(fnorm + cc), f1 = *(const f32x4*)(fnorm + cc + 4);
#pragma unroll
            for (int ai = 0; ai < 2; ++ai)
#pragma unroll
                for (int m = 0; m < 4; ++m) { float* q = op + (size_t)(ai * HALF + wr * 64 + m * 16 + fr) * LDC + cc; asm volatile("" : "+v"(q));
                    *(f32x4*)q = acc[ai][bj][m][0] * rs[ai][m] * f0; *(f32x4*)(q + 4) = acc[ai][bj][m][1] * rs[ai][m] * f1; } }
    }
};
template <class Epi, class Sched, bool ALIGN_EPI = false, bool SP2 = false>
__device__ __forceinline__ void gemm_phase(PG8_LAS unsigned char* lds, const Gemm g, const Sched& S, const Epi& E) {
    int tid_ = threadIdx.x; asm volatile("" : "+v"(tid_));
    const int tid = tid_, wid = __builtin_amdgcn_readfirstlane(tid >> 6), lane = tid & 63, wr = wid >> 2, wc = wid & 3, fr = lane & 15, fq = lane >> 4;
    const int K = g.K, nt = K / BK;
    unsigned voffA[2], voffB[2];
#pragma unroll
    for (int i = 0; i < 2; ++i) { int R, C; stage_rc(tid * 16 + i * 8192, R, C); const int Rb = Epi::PERM ? ((R & ~31) + perm32(R & 31)) : R;
        voffA[i] = (unsigned)(R * K + C) * 2u; voffB[i] = (unsigned)(Rb * K + C) * 2u; }
    const size_t kstep = (size_t)(BK * 2);
    const size_t hstep = (size_t)HALF * K * 2;
    const size_t tstep = 2 * hstep;
    const unsigned ldsw = (unsigned)wid * 1024u;
    const int aoff = lds_byte(wr * 64 + fr, fq * 8), boff = lds_byte(wc * 32 + fr, fq * 8);
#define PG8_SA(b, h) (((b) * 2 + (h)) * HTB)
#define PG8_SB(b, h) ((4 + (b) * 2 + (h)) * HTB)
#define PG8_STAGE(bufoff, gbase, voff) do { _Pragma("unroll") for (int _i = 0; _i < 2; ++_i) \
        __builtin_amdgcn_global_load_lds((const unsigned*)((const char*)(gbase) + (voff)[_i]), (PG8_LAS unsigned*)(lds + (bufoff) + ldsw + _i * 8192), 16, 0, 0); } while (0)
#define PG8_LDA(dst, b, h) do { _Pragma("unroll") for (int m = 0; m < 4; ++m) _Pragma("unroll") for (int k = 0; k < 2; ++k) dst[m][k] = *(const PG8_LAS bf16x8*)(lds + PG8_SA(b, h) + aoff + m * 2048 + k * 1024); } while (0)
#define PG8_LDB(dst, b, h) do { _Pragma("unroll") for (int n = 0; n < 2; ++n) _Pragma("unroll") for (int k = 0; k < 2; ++k) dst[n][k] = *(const PG8_LAS bf16x8*)(lds + PG8_SB(b, h) + boff + n * 2048 + k * 1024); } while (0)
#define PG8_MMA(ai, bj, At, Bt) do { __builtin_amdgcn_s_setprio(1); _Pragma("unroll") for (int m = 0; m < 4; ++m) _Pragma("unroll") for (int n = 0; n < 2; ++n) _Pragma("unroll") for (int k = 0; k < 2; ++k) \
        acc[ai][bj][m][n] = __builtin_amdgcn_mfma_f32_16x16x32_bf16(Bt[n][k], At[m][k], acc[ai][bj][m][n], 0, 0, 0); __builtin_amdgcn_s_setprio(0); } while (0)
#define PG8_WAIT_V(n) asm volatile("s_waitcnt vmcnt(" #n ")" ::: "memory")
#define PG8_WAIT_L(n) asm volatile("s_waitcnt lgkmcnt(" #n ")" ::: "memory")
#define PG8_BAR __builtin_amdgcn_s_barrier()
#define PG8_SCHED __builtin_amdgcn_sched_barrier(0)
    Unit cur, nxt; int ui = 0;
    if (!S.next(0, cur)) return;
    if constexpr (!Sched::SPLIT) { cur.k0b = 0; cur.nt = nt; cur.slice = -1; }
    f32x4 acc[2][2][4][2];
#pragma unroll
    for (int a = 0; a < 2; ++a)
#pragma unroll
        for (int b = 0; b < 2; ++b)
#pragma unroll
            for (int m = 0; m < 4; ++m)
#pragma unroll
                for (int n = 0; n < 2; ++n) acc[a][b][m][n] = (f32x4){0.f, 0.f, 0.f, 0.f};
    bf16x8 At[4][2], B0[2][2], B1[2][2];
    const char* cA = (const char*)g.A + (size_t)cur.pm * tstep + cur.k0b; const char* cB = (const char*)g.Bt + (size_t)cur.pn * tstep + cur.k0b;
    S.a_ready(cur);
    if constexpr (SP2) {
        PG8_STAGE(PG8_SB(0, 0), cB, voffB); PG8_STAGE(PG8_SB(0, 1), cB + hstep, voffB); PG8_STAGE(PG8_SA(0, 0), cA, voffA); PG8_STAGE(PG8_SA(0, 1), cA + hstep, voffA);
        if (wr == 1) PG8_BAR;
        PG8_WAIT_V(2); PG8_BAR;
        PG8_STAGE(PG8_SB(1, 0), cB + kstep, voffB); PG8_STAGE(PG8_SA(1, 0), cA + kstep, voffA); PG8_STAGE(PG8_SB(1, 1), cB + hstep + kstep, voffB);
        PG8_WAIT_V(6); PG8_BAR;
    } else {
        PG8_STAGE(PG8_SB(0, 0), cB, voffB); PG8_STAGE(PG8_SA(0, 0), cA, voffA); PG8_STAGE(PG8_SB(0, 1), cB + hstep, voffB); PG8_STAGE(PG8_SA(0, 1), cA + hstep, voffA);
        if (wr == 1) PG8_BAR;
        PG8_WAIT_V(4); PG8_BAR;
        PG8_STAGE(PG8_SB(1, 0), cB + kstep, voffB); PG8_STAGE(PG8_SA(1, 0), cA + kstep, voffA); PG8_STAGE(PG8_SB(1, 1), cB + hstep + kstep, voffB);
        PG8_WAIT_V(6); PG8_BAR;
    }
    for (;;) {
        if constexpr (Epi::PREFETCH) E.prefetch(cur, ui, tid, wid);
        const bool has_next = S.next(ui + 1, nxt);
        if constexpr (!Sched::SPLIT) { nxt.k0b = 0; nxt.nt = nt; nxt.slice = -1; }
        const int unt = cur.nt;
        const char* nA = has_next ? (const char*)g.A + (size_t)nxt.pm * tstep + nxt.k0b : cA; const char* nB = has_next ? (const char*)g.Bt + (size_t)nxt.pn * tstep + nxt.k0b : cB;
        for (int t = 0; t < unt; t += 2) {
            const bool last = (t == unt - 2);
            const char* a1 = cA + (size_t)(t + 1) * kstep;
            const char* a2 = last ? nA : cA + (size_t)(t + 2) * kstep; const char* b2 = last ? nB : cB + (size_t)(t + 2) * kstep;
            const char* a3 = a2 + kstep; const char* b3 = b2 + kstep;
            if (last && has_next) S.a_ready(nxt);
            if constexpr (SP2) {
            PG8_LDB(B0, 0, 0); PG8_LDB(B1, 0, 1); PG8_SCHED; PG8_LDA(At, 0, 0); PG8_STAGE(PG8_SA(1, 1), a1 + hstep, voffA);
            PG8_WAIT_V(8); PG8_WAIT_L(0); PG8_BAR; PG8_MMA(0, 0, At, B0); PG8_MMA(0, 1, At, B1); PG8_BAR; PG8_SCHED;
            PG8_LDA(At, 0, 1); PG8_STAGE(PG8_SB(0, 0), b2, voffB); PG8_STAGE(PG8_SB(0, 1), b2 + hstep, voffB); PG8_STAGE(PG8_SA(0, 0), a2, voffA);
            PG8_WAIT_V(8); PG8_WAIT_L(0); PG8_BAR; PG8_MMA(1, 0, At, B0); PG8_MMA(1, 1, At, B1); PG8_BAR; PG8_SCHED;
            PG8_LDB(B0, 1, 0); PG8_LDB(B1, 1, 1); PG8_SCHED; PG8_LDA(At, 1, 0); PG8_STAGE(PG8_SA(0, 1), a2 + hstep, voffA);
            PG8_WAIT_V(8); PG8_WAIT_L(0); PG8_BAR; PG8_MMA(0, 0, At, B0); PG8_MMA(0, 1, At, B1); PG8_BAR; PG8_SCHED;
            PG8_LDA(At, 1, 1); PG8_STAGE(PG8_SB(1, 0), b3, voffB); PG8_STAGE(PG8_SB(1, 1), b3 + hstep, voffB); PG8_STAGE(PG8_SA(1, 0), a3, voffA);
            PG8_WAIT_V(8); PG8_WAIT_L(0); PG8_BAR; PG8_MMA(1, 0, At, B0); PG8_MMA(1, 1, At, B1); PG8_BAR; PG8_SCHED;
            } else {
            PG8_LDB(B0, 0, 0); PG8_SCHED; PG8_LDA(At, 0, 0); PG8_STAGE(PG8_SA(1, 1), a1 + hstep, voffA);
            PG8_WAIT_L(8); PG8_BAR; PG8_WAIT_L(0); PG8_MMA(0, 0, At, B0); PG8_BAR; PG8_SCHED;
            PG8_LDB(B1, 0, 1); PG8_STAGE(PG8_SB(0, 0), b2, voffB);
            PG8_BAR; PG8_WAIT_L(0); PG8_MMA(0, 1, At, B1); PG8_BAR;
            PG8_LDA(At, 0, 1); PG8_STAGE(PG8_SA(0, 0), a2, voffA);
            PG8_BAR; PG8_WAIT_L(0); PG8_MMA(1, 0, At, B0); PG8_BAR; PG8_SCHED;
            PG8_STAGE(PG8_SB(0, 1), b2 + hstep, voffB);
            PG8_WAIT_V(6); PG8_BAR; PG8_MMA(1, 1, At, B1); PG8_BAR;
            PG8_LDB(B0, 1, 0); PG8_SCHED; PG8_LDA(At, 1, 0); PG8_STAGE(PG8_SA(0, 1), a2 + hstep, voffA);
            PG8_WAIT_L(8); PG8_BAR; PG8_WAIT_L(0); PG8_MMA(0, 0, At, B0); PG8_BAR; PG8_SCHED;
            PG8_LDB(B1, 1, 1); PG8_STAGE(PG8_SB(1, 0), b3, voffB);
            PG8_BAR; PG8_WAIT_L(0); PG8_MMA(0, 1, At, B1); PG8_BAR;
            PG8_LDA(At, 1, 1); PG8_STAGE(PG8_SA(1, 0), a3, voffA);
            PG8_BAR; PG8_WAIT_L(0); PG8_MMA(1, 0, At, B0); PG8_BAR; PG8_SCHED;
            PG8_STAGE(PG8_SB(1, 1), b3 + hstep, voffB);
            PG8_WAIT_V(6); PG8_BAR; PG8_MMA(1, 1, At, B1); PG8_BAR;
            }
        }
        if constexpr (ALIGN_EPI) { if (wr == 0) PG8_BAR; }
        if constexpr (!Epi::AFTER_DRAIN) { if constexpr (Epi::PREFETCH) E(acc, cur, wr, wc, fr, fq, ui); else E(acc, cur, wr, wc, fr, fq); S.done(cur); }
        if (!has_next) break;
#pragma unroll
        for (int a = 0; a < 2; ++a)
#pragma unroll
            for (int b = 0; b < 2; ++b)
#pragma unroll
                for (int m = 0; m < 4; ++m)
#pragma unroll
                    for (int n = 0; n < 2; ++n) acc[a][b][m][n] = (f32x4){0.f, 0.f, 0.f, 0.f};
        cur = nxt; cA = nA; cB = nB; ++ui;
        if constexpr (ALIGN_EPI) { if (wr == 1) PG8_BAR; }
    }
    PG8_WAIT_V(0);
    if constexpr (!ALIGN_EPI) { if (wr == 0) PG8_BAR; }
    PG8_BAR;
    if constexpr (Epi::AFTER_DRAIN) { E.fused(acc, cur, wr, wc, fr, fq, lds, wid, lane); S.done(cur); }
#undef PG8_SA
#undef PG8_SB
#undef PG8_STAGE
#undef PG8_LDA
#undef PG8_LDB
#undef PG8_MMA
#undef PG8_WAIT_V
#undef PG8_WAIT_L
#undef PG8_BAR
#undef PG8_SCHED
}
}
#include <hip/hip_bf16.h>
#include <cmath>
namespace attn_body {
using bf16=__hip_bfloat16;
using bf16x8=__attribute__((ext_vector_type(8)))short;
using s16x4=__attribute__((ext_vector_type(4)))short;
using f32x16=__attribute__((ext_vector_type(16)))float;
using u32x4=__attribute__((ext_vector_type(4)))unsigned;
constexpr int D=64,QP=1024,KP=128;
constexpr int NW=8,QBLK=32,QB=QBLK*NW,KVBLK=64;
__device__ __forceinline__ int crow(int r,int hi){return (r&3)+8*(r>>2)+4*hi;}
#define SBAR() __builtin_amdgcn_sched_barrier(0)
__device__ __forceinline__ void cmask(f32x16&p0,f32x16&p1,int jb,int qrel,int hi){
  const float NEG=-INFINITY; int kb=64*jb+4*hi;
  #pragma unroll
  for(int r=0;r<16;++r){int kv=kb+(r&3)+8*(r>>2); if(kv>qrel)p0[r]=NEG; if(kv+32>qrel)p1[r]=NEG;}
}

constexpr int NSLOT=3, SLOTB=8192;
constexpr int LDS_K=0, LDS_V=NSLOT*SLOTB, LDS_WS=2*NSLOT*SLOTB, LDS_OST=LDS_WS+NW*64*4, LDS_BYTES=LDS_OST+NW*4096;
constexpr float C2=0.125f*1.4426950408889634f;
__device__ __forceinline__ void glds16(const void*gsrc,unsigned lds_dst){unsigned keep;
  asm volatile("s_mov_b32 %0, m0\n\ts_mov_b32 m0, %2\n\ts_nop 0\n\tglobal_load_lds_dwordx4 %1, off\n\ts_mov_b32 m0, %0":"=&s"(keep):"v"(gsrc),"s"(lds_dst):"memory");}
__device__ __forceinline__ float max3f(float a,float b,float c){float r;asm("v_max3_f32 %0, %1, %2, %3":"=v"(r):"v"(a),"v"(b),"v"(c));return r;}
__device__ __forceinline__ float max2f(float a,float b){float r;asm("v_max_f32_e32 %0, %1, %2":"=v"(r):"v"(a),"v"(b));return r;}
__device__ __forceinline__ float fadd_s(float a,float b){float r;asm("v_add_f32_e32 %0, %1, %2":"=v"(r):"v"(a),"v"(b));return r;}
__device__ __forceinline__ float fsub_s(float a,float b){float r;asm("v_sub_f32_e32 %0, %1, %2":"=v"(r):"v"(a),"v"(b));return r;}
typedef float f32x2_t __attribute__((ext_vector_type(2))); typedef __bf16 bf16x2_t __attribute__((ext_vector_type(2)));
__device__ __forceinline__ unsigned cvtpk_s(float lo,float hi){f32x2_t v={lo,hi};bf16x2_t b=__builtin_convertvector(v,bf16x2_t);return __builtin_bit_cast(unsigned,b);}
#define WAIT_BAR(N) asm volatile("s_waitcnt vmcnt(" #N ") lgkmcnt(0)\n\ts_barrier":::"memory")

__device__ __forceinline__ void qkt(f32x16&p0,f32x16&p1,const char*Kslot,const bf16x8*qr,const f32x16&negm,int r32,int hi){
  const char*kb=Kslot+hi*1024+r32*16;
  #pragma unroll
  for(int d0=0;d0<4;++d0){
    const bf16x8 b0=*reinterpret_cast<const bf16x8*>(kb+d0*2048);
    const bf16x8 b1=*reinterpret_cast<const bf16x8*>(kb+d0*2048+512);
    if(d0==0){p0=__builtin_amdgcn_mfma_f32_32x32x16_bf16(b0,qr[0],negm,0,0,0);p1=__builtin_amdgcn_mfma_f32_32x32x16_bf16(b1,qr[0],negm,0,0,0);}
    else{p0=__builtin_amdgcn_mfma_f32_32x32x16_bf16(b0,qr[d0],p0,0,0,0);p1=__builtin_amdgcn_mfma_f32_32x32x16_bf16(b1,qr[d0],p1,0,0,0);}}
}
typedef __attribute__((address_space(3))) const char* lds_cptr;
typedef short v4i16_t __attribute__((ext_vector_type(4)));
__device__ __forceinline__ void kload8(bf16x8*kf,lds_cptr kp){
  kf[0]=*(const __attribute__((address_space(3))) bf16x8*)(kp);      kf[1]=*(const __attribute__((address_space(3))) bf16x8*)(kp+512);
  kf[2]=*(const __attribute__((address_space(3))) bf16x8*)(kp+2048); kf[3]=*(const __attribute__((address_space(3))) bf16x8*)(kp+2560);
  kf[4]=*(const __attribute__((address_space(3))) bf16x8*)(kp+4096); kf[5]=*(const __attribute__((address_space(3))) bf16x8*)(kp+4608);
  kf[6]=*(const __attribute__((address_space(3))) bf16x8*)(kp+6144); kf[7]=*(const __attribute__((address_space(3))) bf16x8*)(kp+6656);
}
__device__ __forceinline__ void kload2(bf16x8*kf,lds_cptr kp,int j){ kf[2*j]=*(const __attribute__((address_space(3))) bf16x8*)(kp+j*2048); kf[2*j+1]=*(const __attribute__((address_space(3))) bf16x8*)(kp+j*2048+512); }
__device__ __forceinline__ s16x4 vtr(lds_cptr p){ return __builtin_bit_cast(s16x4,__builtin_amdgcn_ds_read_tr16_b64_v4i16((__attribute__((address_space(3))) v4i16_t*)p)); }
__device__ __forceinline__ float rowmax(const f32x16&p0,const f32x16&p1){
  float a=max3f(p0[0],p0[1],p1[0]),b=max3f(p0[2],p0[3],p1[1]);a=max3f(a,p1[2],p1[3]);
  #pragma unroll
  for(int r=4;r<16;r+=4){a=max3f(a,p0[r],p0[r+1]);b=max3f(b,p0[r+2],p0[r+3]);a=max3f(a,p1[r],p1[r+1]);b=max3f(b,p1[r+2],p1[r+3]);}
  const float m=max2f(a,b);
  auto rr=__builtin_amdgcn_permlane32_swap(__float_as_uint(m),__float_as_uint(m),false,false);
  return max2f(__uint_as_float(rr[0]),__uint_as_float(rr[1]));
}
__device__ __forceinline__ void pv(f32x16*o,int vb,bf16x8 pa0,bf16x8 pa1,bf16x8 pa2,bf16x8 pa3){
  #pragma unroll
  for(int d0=0;d0<2;++d0){s16x4 lo[4],hi[4];
    #pragma unroll
    for(int ks=0;ks<4;++ks){
      asm volatile("ds_read_b64_tr_b16 %0,%1 offset:%c2":"=&v"(lo[ks]):"v"(vb),"i"(d0*4096+ks*1024):"memory");
      asm volatile("ds_read_b64_tr_b16 %0,%1 offset:%c2":"=&v"(hi[ks]):"v"(vb),"i"(d0*4096+ks*1024+512):"memory");}
    asm volatile("s_waitcnt lgkmcnt(0)":::"memory");SBAR();
    #define PK(k) (bf16x8){lo[k][0],lo[k][1],lo[k][2],lo[k][3],hi[k][0],hi[k][1],hi[k][2],hi[k][3]}
    o[d0]=__builtin_amdgcn_mfma_f32_32x32x16_bf16(pa0,PK(0),o[d0],0,0,0);
    o[d0]=__builtin_amdgcn_mfma_f32_32x32x16_bf16(pa1,PK(1),o[d0],0,0,0);
    o[d0]=__builtin_amdgcn_mfma_f32_32x32x16_bf16(pa2,PK(2),o[d0],0,0,0);
    o[d0]=__builtin_amdgcn_mfma_f32_32x32x16_bf16(pa3,PK(3),o[d0],0,0,0);
    #undef PK
  }
}

#ifndef ATTN_STORE16
#define ATTN_STORE16(p,v) (*(u32x4*)(p)=(v))
#endif
template<int THRL> __device__ __forceinline__ void attn_unit(const bf16*Qw0,const bf16*__restrict__ Kh,const bf16*__restrict__ Vh,bf16*Ow0,const int NT,char*shm){
  int tid_=threadIdx.x; asm volatile("":"+v"(tid_)); const int tid=tid_,lane=tid&63,r32=lane&31,hi=lane>>5; const int wid=__builtin_amdgcn_readfirstlane(tid>>6);
  const bf16*Qw=Qw0+(long)(wid*QBLK)*QP;
  const unsigned lds0=(unsigned)(uintptr_t)shm;
  float*wsf=(float*)(shm+LDS_WS)+wid*64;
  const bf16*ksrc=Kh+(long)lane*KP+wid*8;
  const bf16*vsrc=Vh+(long)(16*(wid&3)+(lane>>2))*KP+(wid>>2)*32+(lane&3)*8;
  const unsigned kdst=lds0+LDS_K+wid*1024, vdst=lds0+LDS_V+wid*1024;
  #define DMA_K(t,slot) glds16(ksrc+(long)(t)*KVBLK*KP,(unsigned)__builtin_amdgcn_readfirstlane(kdst+(slot)))
  #define DMA_V(t,slot) glds16(vsrc+(long)(t)*KVBLK*KP,(unsigned)__builtin_amdgcn_readfirstlane(vdst+(slot)))
  const int vb0=(int)(lds0+LDS_V)+((lane>>4)&1)*32+(lane&3)*8+(4*hi+((lane&15)>>2))*64;
  const char*Kbase=shm+LDS_K; bf16x8 kf[8];
  const lds_cptr shm3=(lds_cptr)shm; const lds_cptr kp0=shm3+LDS_K+hi*1024+r32*16; const lds_cptr vp0=shm3+LDS_V+((lane>>4)&1)*32+(lane&3)*8+(4*hi+((lane&15)>>2))*64;
  DMA_K(0,0);DMA_V(0,0);DMA_K(1,SLOTB);
  bf16x8 qr[4];
  #pragma unroll
  for(int d0=0;d0<4;++d0)qr[d0]=*reinterpret_cast<const bf16x8*>(&Qw[(long)r32*QP+d0*16+hi*8]);
  float mhat=0.f,l_reg=0.f;f32x16 o[2];o[0]=f32x16{};o[1]=f32x16{};f32x16 negm=f32x16{};asm volatile("":"+v"(negm));
  #define CMASK(P0,P1,t) do{}while(0)
  bool resc=false;
  #define START(P0,P1) do{ const float rm=rowmax(P0,P1); resc=false; \
    { const float dl=rm; mhat=fadd_s(mhat,dl); \
      _Pragma("unroll") for(int r=0;r<16;++r){P0[r]=fsub_s(P0[r],dl);P1[r]=fsub_s(P1[r],dl);} \
      _Pragma("unroll") for(int r=0;r<16;++r)negm[r]=-mhat; asm volatile("":"+v"(negm)); } \
    _Pragma("unroll") for(int r=0;r<16;++r)P0[r]=__builtin_amdgcn_exp2f(P0[r]); }while(0)
  #define RESC() do{ if(resc){ asm volatile("s_waitcnt lgkmcnt(0)":::"memory"); \
      _Pragma("unroll") for(int d_=0;d_<2;++d_) _Pragma("unroll") for(int r=0;r<16;++r)o[d_][r]*=wsf[crow(r,hi)]; } }while(0)
  f32x16 pA0,pA1,pB0,pB1;
  int sl_prev=0,sl_cur=0,sl_next=SLOTB;
  #define ROT() do{sl_prev=sl_cur;sl_cur=sl_next;sl_next=(sl_next==(NSLOT-1)*SLOTB)?0:sl_next+SLOTB;}while(0)
  DMA_K(2,2*SLOTB);
  WAIT_BAR(3);
  qkt(pA0,pA1,Kbase,qr,negm,r32,hi);asm volatile("s_nop 15\n\ts_nop 7":"+v"(pA0),"+v"(pA1));CMASK(pA0,pA1,0);
  START(pA0,pA1);
  _Pragma("unroll") for(int r=0;r<16;++r)pA1[r]=__builtin_amdgcn_exp2f(pA1[r]);
  WAIT_BAR(0);
  DMA_K(3,0);DMA_V(1,SLOTB);
  ROT();
  kload8(kf,kp0+sl_cur);
  WAIT_BAR(2);
  s16x4 vlo[8],vhi[8]; u32x4 pw0,pw1,pw2,pw3;
  #define PKW(P,B) cvtpk_s(P[B],P[B+1])
  #define PAF(k) __builtin_bit_cast(bf16x8,pw##k)
  #define VFR(i) (bf16x8){vlo[i][0],vlo[i][1],vlo[i][2],vlo[i][3],vhi[i][0],vhi[i][1],vhi[i][2],vhi[i][3]}
  #define PIN(x) asm volatile("":"+v"(x))
  #define MX3(a,b,c) __builtin_fmaxf(__builtin_fmaxf((a),(b)),(c))
  #define GAPA(MF,A0,A1,A2,A3,W0,W1,PW) do{ MF; sacc+=A0; sacc+=A1; sacc+=A2; sacc+=A3; PIN(sacc); W0; W1; PIN(PW); SBAR(); }while(0)
  #define EX(v) __builtin_amdgcn_exp2f(v)
  #define GAPB(MF,X,B) do{ MF; X[B]=EX(X[B]); X[B+1]=EX(X[B+1]); X[B+2]=EX(X[B+2]); X[B+3]=EX(X[B+3]); PIN(X); SBAR(); }while(0)
  #define VRD(i) do{ vlo[i]=vtr(vp_+(((i)>>2)*4096+((i)&3)*1024)); vhi[i]=vtr(vp_+(((i)>>2)*4096+((i)&3)*1024+512)); }while(0)
  #define KRD(G,j) do{ if(G){ kload2(kf,kp0+sl_next,j); SBAR(); } }while(0)
  #define STEP(C0,C1,P0,P1,t,GK,GV,GL) do{ SBAR(); \
    const lds_cptr vp_=vp0+sl_prev; \
    VRD(0); SBAR(); float sacc=(P0[0]+P0[1]); \
    GAPA(C0=__builtin_amdgcn_mfma_f32_32x32x16_bf16(kf[0],qr[0],negm,0,0,0), P0[2],P0[3],P0[4],P0[5],     pw0[0]=PKW(P0,0), pw0[1]=PKW(P0,2), pw0); \
    VRD(4); SBAR(); GAPA(C1=__builtin_amdgcn_mfma_f32_32x32x16_bf16(kf[1],qr[0],negm,0,0,0), P0[6],P0[7],P0[8],P0[9],     pw0[2]=PKW(P0,4), pw0[3]=PKW(P0,6), pw0); \
    VRD(1); SBAR(); GAPA(C0=__builtin_amdgcn_mfma_f32_32x32x16_bf16(kf[2],qr[1],C0,0,0,0),   P0[10],P0[11],P0[12],P0[13], pw1[0]=PKW(P0,8), pw1[1]=PKW(P0,10), pw1); \
    VRD(5); SBAR(); GAPA(C1=__builtin_amdgcn_mfma_f32_32x32x16_bf16(kf[3],qr[1],C1,0,0,0),   P0[14],P0[15],P1[0],P1[1],   pw1[2]=PKW(P0,12),pw1[3]=PKW(P0,14), pw1); \
    VRD(2); SBAR(); GAPA(C0=__builtin_amdgcn_mfma_f32_32x32x16_bf16(kf[4],qr[2],C0,0,0,0),   P1[2],P1[3],P1[4],P1[5],     pw2[0]=PKW(P1,0), pw2[1]=PKW(P1,2), pw2); \
    VRD(6); SBAR(); GAPA(C1=__builtin_amdgcn_mfma_f32_32x32x16_bf16(kf[5],qr[2],C1,0,0,0),   P1[6],P1[7],P1[8],P1[9],     pw2[2]=PKW(P1,4), pw2[3]=PKW(P1,6), pw2); \
    VRD(3); SBAR(); GAPA(C0=__builtin_amdgcn_mfma_f32_32x32x16_bf16(kf[6],qr[3],C0,0,0,0),   P1[10],P1[11],P1[12],P1[13], pw3[0]=PKW(P1,8), pw3[1]=PKW(P1,10), pw3); \
    VRD(7); SBAR(); GAPA(C1=__builtin_amdgcn_mfma_f32_32x32x16_bf16(kf[7],qr[3],C1,0,0,0),   P1[14],P1[15],0.f,0.f,       pw3[2]=PKW(P1,12),pw3[3]=PKW(P1,14), pw3); \
    l_reg+=sacc; \
    if(GK){DMA_K((t)+3,sl_cur);} if(GV){DMA_V((t)+1,sl_next);} \
    CMASK(C0,C1,t); \
    { float a=MX3(C0[0],C0[1],C1[0]),b=MX3(C0[2],C0[3],C1[1]); a=MX3(a,C1[2],C1[3]); \
      _Pragma("unroll") for(int r=4;r<16;r+=4){a=MX3(a,C0[r],C0[r+1]);b=MX3(b,C0[r+2],C0[r+3]);a=MX3(a,C1[r],C1[r+1]);b=MX3(b,C1[r+2],C1[r+3]);} \
      float rm=__builtin_fmaxf(a,b); { auto rr=__builtin_amdgcn_permlane32_swap(__float_as_uint(rm),__float_as_uint(rm),false,false); rm=__builtin_fmaxf(__uint_as_float(rr[0]),__uint_as_float(rr[1])); } \
      resc=false; \
      if(__builtin_expect(__any(rm>(float)THRL),0)){ const float dl=__builtin_fmaxf(rm,0.f); mhat+=dl; \
        _Pragma("unroll") for(int r=0;r<16;++r){C0[r]-=dl;C1[r]-=dl;} \
        _Pragma("unroll") for(int r=0;r<16;++r)negm[r]=-mhat; asm volatile("":"+v"(negm)); \
        const float f=__builtin_amdgcn_exp2f(-dl); l_reg*=f; if(hi==0)wsf[r32]=f; resc=true; } } \
    SBAR(); \
    GAPB(o[0]=__builtin_amdgcn_mfma_f32_32x32x16_bf16(PAF(0),VFR(0),o[0],0,0,0), C0,0); \
    GAPB(o[1]=__builtin_amdgcn_mfma_f32_32x32x16_bf16(PAF(0),VFR(4),o[1],0,0,0), C0,4); \
    KRD(GL,0); GAPB(o[0]=__builtin_amdgcn_mfma_f32_32x32x16_bf16(PAF(1),VFR(1),o[0],0,0,0), C0,8); \
    KRD(GL,1); GAPB(o[1]=__builtin_amdgcn_mfma_f32_32x32x16_bf16(PAF(1),VFR(5),o[1],0,0,0), C0,12); \
    KRD(GL,2); GAPB(o[0]=__builtin_amdgcn_mfma_f32_32x32x16_bf16(PAF(2),VFR(2),o[0],0,0,0), C1,0); \
    KRD(GL,3); GAPB(o[1]=__builtin_amdgcn_mfma_f32_32x32x16_bf16(PAF(2),VFR(6),o[1],0,0,0), C1,4); \
    GAPB(o[0]=__builtin_amdgcn_mfma_f32_32x32x16_bf16(PAF(3),VFR(3),o[0],0,0,0), C1,8); \
    GAPB(o[1]=__builtin_amdgcn_mfma_f32_32x32x16_bf16(PAF(3),VFR(7),o[1],0,0,0), C1,12); \
    }while(0)
  int t=1;
  for(;t+5<NT;t+=2){
    STEP(pB0,pB1,pA0,pA1,t,true,true,true);     WAIT_BAR(2); RESC(); ROT();
    STEP(pA0,pA1,pB0,pB1,t+1,true,true,true);   WAIT_BAR(2); RESC(); ROT();
  }
  #define ENDW(tt) do{ if((tt)+3<NT){WAIT_BAR(2);} else if((tt)+2<NT){WAIT_BAR(1);} else {WAIT_BAR(0);} }while(0)
  for(;t+1<NT;t+=2){
    STEP(pB0,pB1,pA0,pA1,t,(t+3<NT),(t+1<NT),(t+1<NT));       ENDW(t);   RESC(); ROT();
    STEP(pA0,pA1,pB0,pB1,t+1,(t+4<NT),(t+2<NT),(t+2<NT));     ENDW(t+1); RESC(); ROT();
  }
  STEP(pB0,pB1,pA0,pA1,NT-1,false,false,false); RESC();
  { float sacc=pB0[0]+pB0[1]; _Pragma("unroll") for(int r=2;r<16;++r)sacc+=pB0[r]; _Pragma("unroll") for(int r=0;r<16;++r)sacc+=pB1[r]; l_reg+=sacc;
    pw0=(u32x4){PKW(pB0,0),PKW(pB0,2),PKW(pB0,4),PKW(pB0,6)};pw1=(u32x4){PKW(pB0,8),PKW(pB0,10),PKW(pB0,12),PKW(pB0,14)};pw2=(u32x4){PKW(pB1,0),PKW(pB1,2),PKW(pB1,4),PKW(pB1,6)};pw3=(u32x4){PKW(pB1,8),PKW(pB1,10),PKW(pB1,12),PKW(pB1,14)};
    SBAR(); pv(o,vb0+sl_cur,PAF(0),PAF(1),PAF(2),PAF(3)); }
  #undef PKW
  #undef PAF
  #undef VFR
  #undef PIN
  #undef MX3
  #undef GAPA
  #undef GAPB
  #undef EX
  #undef VRD
  #undef KRD
  #undef STEP
  #undef ENDW
  {auto rr=__builtin_amdgcn_permlane32_swap(__float_as_uint(l_reg),__float_as_uint(l_reg),false,false);l_reg=__uint_as_float(rr[0])+__uint_as_float(rr[1]);}
  if(hi==0)wsf[32+r32]=l_reg;asm volatile("s_waitcnt lgkmcnt(0)":::"memory");
  float rli[16];
  #pragma unroll
  for(int r=0;r<16;++r)rli[r]=__builtin_amdgcn_rcpf(wsf[32+crow(r,hi)]);
  bf16*Ow=Ow0+(long)(wid*QBLK)*QP;
  { bf16*stg=(bf16*)(shm+LDS_OST)+wid*2048;
    #pragma unroll
    for(int r=0;r<16;++r){const int orow=crow(r,hi);
      #pragma unroll
      for(int d0=0;d0<2;++d0)stg[orow*64+d0*32+r32]=__float2bfloat16(o[d0][r]*rli[r]);}
    asm volatile("s_waitcnt lgkmcnt(0)":::"memory");
    #pragma unroll
    for(int i=0;i<4;++i){const int row=i*8+(lane>>3),ch=lane&7; const u32x4 v=*(const u32x4*)(stg+row*64+ch*8); ATTN_STORE16(Ow+(long)row*QP+ch*8,v);} }
  asm volatile("s_waitcnt lgkmcnt(0)\n\ts_barrier":::"memory");
  #undef DMA_K
  #undef DMA_V
  #undef CMASK
  #undef START
  #undef RESC
  #undef ROT
}
constexpr int ATTN_LDS_BYTES=LDS_BYTES;
#undef SBAR
#undef WAIT_BAR
}
constexpr int NWAVES = 8, NTHR = 512;
constexpr int DMODEL = 1024, NBATCH = 8, SEQ = 2048, CTXL = 256, DEPTH = 2;
constexpr int NLAT = NBATCH * SEQ, NCTX = NBATCH * CTXL, MT = NLAT + NCTX;
constexpr int INW = 1536, FF = 2816, NKEY = CTXL + SEQ, KVW = 128, MODW = 6144;
constexpr int O_K = 512, O_V = 640, O_G = 768, O_P = 1280;
constexpr float EPS = 1e-6f;
constexpr size_t MiB = 1u << 20;
constexpr size_t WS_CTL = 0, CTL_ZERO_BYTES = 1 * MiB;
constexpr size_t WS_MOD = 64 * 1024;
constexpr size_t WS_ROPE = 1 * MiB;
constexpr size_t WS_WS = WS_ROPE + 512 * 1024;
constexpr size_t WS_PW = WS_WS + 256 * 1024;
constexpr size_t WS_WIN = 2 * MiB, WS_WOUT = 8 * MiB, WS_WGU = 12 * MiB, WS_WDN = 34 * MiB;
constexpr size_t WS_CTXRES = 45 * MiB;
constexpr size_t WS_H = 53 * MiB;
constexpr size_t WS_ACT = 89 * MiB;
constexpr size_t WS_Z = 89 * MiB, WS_MIX = 143 * MiB, WS_KB = 179 * MiB, WS_VB = WS_KB + 4608 * 1024;
constexpr size_t WS_BIAS = 188 * MiB;
constexpr size_t WS_END = 189 * MiB;
constexpr size_t WS_SLAB = 192 * MiB; constexpr int KSPLIT = 4;
constexpr size_t WS_XH = 224 * MiB;
static_assert(WS_SLAB + (size_t)32 * KSPLIT * 65536 * 4 <= WS_XH && WS_XH + (size_t)NLAT * DMODEL * 2 <= 256 * MiB, "slabs / fp16 stream inside 256 MiB");
constexpr size_t WS_RSSV = 872 * 1024;
constexpr size_t WS_RSS = 512 * 1024;
static_assert((4096 + 3456) * 4 <= 64 * 1024, "barrier words below the mod accumulators");
static_assert(WS_MOD + (size_t)DEPTH * 9 * MODW * 4 <= WS_RSS && WS_RSS + (size_t)5 * MT * 4 <= WS_RSSV && WS_RSSV + (size_t)DEPTH * MT * 4 <= CTL_ZERO_BYTES, "mod / rss inside memset region");
static_assert(WS_Z + (size_t)MT * INW * 2 <= WS_MIX && WS_MIX + (size_t)MT * 1024 * 2 <= WS_KB && WS_VB + (size_t)NBATCH * NKEY * KVW * 2 <= WS_END && WS_ACT + (size_t)MT * FF * 2 <= WS_END, "ws map");
static_assert(WS_WIN + (size_t)DEPTH * INW * 1024 * 2 <= WS_WOUT && WS_WOUT + (size_t)DEPTH * 1024 * 1024 * 2 <= WS_WGU && WS_WGU + (size_t)DEPTH * 2 * FF * 1024 * 2 <= WS_WDN && WS_WDN + (size_t)DEPTH * 1024 * FF * 2 <= WS_CTXRES, "ws map 2");
constexpr int LDSCTL_OFF = 131072, MISC_OFF = LDSCTL_OFF + 320;
constexpr int LDS_BYTES = 147456;

#define LAS __attribute__((address_space(3)))
typedef unsigned short bf16;
typedef unsigned v4u __attribute__((ext_vector_type(4)));
typedef unsigned v2u __attribute__((ext_vector_type(2)));
typedef float f32x4 __attribute__((ext_vector_type(4)));
typedef short bf16x8 __attribute__((ext_vector_type(8)));
#define LDS_WAIT() asm volatile("s_waitcnt lgkmcnt(0)" ::: "memory")
__device__ __forceinline__ unsigned f2bf(float f) { unsigned u = __builtin_bit_cast(unsigned, f); return (u + 0x7fffu + ((u >> 16) & 1u)) >> 16; }
__device__ __forceinline__ unsigned pk2(float lo, float hi) { return f2bf(lo) | (f2bf(hi) << 16); }
__device__ __forceinline__ float bflo(unsigned w) { return __builtin_bit_cast(float, w << 16); }
__device__ __forceinline__ float bfhi(unsigned w) { return __builtin_bit_cast(float, w & 0xffff0000u); }
__device__ __forceinline__ void unpack8(const v4u r, float (&f)[8]) { f[0] = bflo(r.x); f[1] = bfhi(r.x); f[2] = bflo(r.y); f[3] = bfhi(r.y); f[4] = bflo(r.z); f[5] = bfhi(r.z); f[6] = bflo(r.w); f[7] = bfhi(r.w); }
__device__ __forceinline__ v4u pack8(const float (&f)[8]) { v4u o; o.x = pk2(f[0], f[1]); o.y = pk2(f[2], f[3]); o.z = pk2(f[4], f[5]); o.w = pk2(f[6], f[7]); return o; }
__device__ __forceinline__ float wave_sum(float v) {
#pragma unroll
    for (int o = 1; o < 64; o <<= 1) v += __shfl_xor(v, o);
    return v;
}
__device__ __forceinline__ float gelu_tanh(float x) {
    const float y = 0.7978845608028654f * (x + 0.044715f * x * x * x);
    const float e = __builtin_amdgcn_exp2f(y * -2.8853900817779268f);
    return x * __builtin_amdgcn_rcpf(1.0f + e);
}

#define RLX_AGENT __ATOMIC_RELAXED, __HIP_MEMORY_SCOPE_AGENT
#define XB_TMO      128
#define XB_XCNT(j)  (256  + 64 * (j))
#define XB_XSUB(j)  (1280 + 64 * (j))
#define XB_XGEN(j)  (2304 + 64 * (j))
#define XB_TOP      3328
#define XB_TOPGEN   3392
#define XCD_BAR_WORDS 3456
#define XB_SPIN_CAP (1u << 18)

__device__ __forceinline__ unsigned xb_ld(unsigned* p)              { return __hip_atomic_load(p, __ATOMIC_RELAXED, __HIP_MEMORY_SCOPE_AGENT); }
__device__ __forceinline__ unsigned xb_add(unsigned* p, unsigned v) { return __hip_atomic_fetch_add(p, v, __ATOMIC_RELAXED, __HIP_MEMORY_SCOPE_AGENT); }
__device__ __forceinline__ unsigned xb_xcc_id() { return (unsigned)__builtin_amdgcn_s_getreg((3 << 11) | 20) & 0xFu; }
#define XB_SPIN(cond, bar) do { unsigned _sp = 0; while (cond) { __builtin_amdgcn_s_sleep(1); \
    if ((++_sp & 255u) == 0u) { if (xb_ld(&(bar)[XB_TMO])) break; if (_sp > XB_SPIN_CAP) { atomicAdd(&(bar)[XB_TMO], 1u); break; } } } } while (0)

struct XcdBarrier {
    unsigned* bar; unsigned x;
    volatile LAS unsigned* st;
};

__device__ __forceinline__ XcdBarrier xcd_barrier_post(unsigned* bar, volatile LAS unsigned* st) {
    XcdBarrier b; b.bar = bar; b.x = xb_xcc_id(); b.st = st;
    if (threadIdx.x == 0) (void)xb_add(&bar[XB_XCNT(b.x)], 1u);
    return b;
}
__device__ __forceinline__ void xcd_barrier_complete(unsigned* bar, unsigned x, unsigned& nloc, unsigned& nx) {
    const unsigned G = gridDim.x * gridDim.y * gridDim.z;
    unsigned sum, cnt, mine, sp = 0u;
    for (;;) {
        sum = 0u; cnt = 0u; mine = 0u;
#pragma unroll
        for (unsigned j = 0; j < 16; ++j) { const unsigned c = xb_ld(&bar[XB_XCNT(j)]); sum += c; cnt += (c > 0u) ? 1u : 0u; mine = (j == x) ? c : mine; }
        if (sum == G) break;
        __builtin_amdgcn_s_sleep(1);
        if ((++sp & 255u) == 0u) { if (xb_ld(&bar[XB_TMO])) break; if (sp > XB_SPIN_CAP) { atomicAdd(&bar[XB_TMO], 1u); break; } }
    }
    nloc = mine > 0u ? mine : 1u; nx = cnt > 0u ? cnt : 1u;
}

__device__ __forceinline__ void xcd_barrier(const XcdBarrier& b) {
    asm volatile("s_waitcnt vmcnt(0)" ::: "memory");
    __syncthreads();
    if (threadIdx.x == 0) {
        unsigned* bar = b.bar;
        __builtin_amdgcn_s_waitcnt(0);
        unsigned nloc = b.st[0], nx = b.st[1];
        if (nloc == 0u) { xcd_barrier_complete(bar, b.x, nloc, nx); b.st[0] = nloc; b.st[1] = nx; }
        const unsigned old = xb_add(&bar[XB_XSUB(b.x)], 1u);
        const unsigned gen = old / nloc;
        if (old + 1u == (gen + 1u) * nloc) {
            __builtin_amdgcn_fence(__ATOMIC_RELEASE, "agent");
            asm volatile("s_waitcnt vmcnt(0)" ::: "memory");
            const unsigned og = xb_add(&bar[XB_TOP], 1u);
            const unsigned tg = og / nx;
            if (og + 1u == (tg + 1u) * nx) xb_add(&bar[XB_TOPGEN], 1u);
            else XB_SPIN(xb_ld(&bar[XB_TOPGEN]) == tg, bar);
            __builtin_amdgcn_fence(__ATOMIC_ACQUIRE, "agent");
            xb_add(&bar[XB_XGEN(b.x)], 1u);
            asm volatile("s_waitcnt vmcnt(0)" ::: "memory");
        } else {
            XB_SPIN(xb_ld(&bar[XB_XGEN(b.x)]) == gen, bar);
            __builtin_amdgcn_fence(__ATOMIC_ACQUIRE, "agent");
            asm volatile("s_waitcnt vmcnt(0)" ::: "memory");
        }
    }
    __syncthreads();
}

constexpr int CW_PANEL = 8192;
constexpr int CW_BAR = 4096;
struct Args { const float* in[21]; float* out; unsigned char* ws; unsigned long long pad; };
struct Frame {
    LAS unsigned char* lds;
    int tid, lane, wave, vcu, G;
    float* out; unsigned char* ws;
};

__device__ __forceinline__ void relaunder(Frame& F) { int t = threadIdx.x; asm volatile("" : "+v"(t)); F.tid = t; F.lane = t & 63; F.wave = __builtin_amdgcn_readfirstlane(t >> 6); }
__device__ __forceinline__ void p0_transpose_item(const float* W, int K, int N, bf16* WT, int k0, int n0, int drow0, LAS float* scr, int lane) {
    float tv[32];
#pragma unroll
    for (int i = 0; i < 32; ++i) tv[i] = __builtin_nontemporal_load(&W[(size_t)(k0 + 2 * i + (lane >> 5)) * N + n0 + (lane & 31)]);
#pragma unroll
    for (int i = 0; i < 32; ++i) scr[(2 * i + (lane >> 5)) * 33 + (lane & 31)] = tv[i];
    LDS_WAIT(); asm volatile("" ::: "memory");
    const int c = lane & 7;
#pragma unroll
    for (int j = 0; j < 4; ++j) { const int n = (lane >> 3) + 8 * j; const LAS float* s = scr + (8 * c) * 33 + n;
        v4u o; o.x = pk2(s[0 * 33], s[1 * 33]); o.y = pk2(s[2 * 33], s[3 * 33]); o.z = pk2(s[4 * 33], s[5 * 33]); o.w = pk2(s[6 * 33], s[7 * 33]);
        *(v4u*)(WT + (size_t)(drow0 + n) * K + k0 + 8 * c) = o; }
    LDS_WAIT(); asm volatile("" ::: "memory");
}
__device__ __forceinline__ void transpose_set(const Args& A, Frame& F, int set, int widx, int nw) {
    LAS float* scr = (LAS float*)(F.lds + F.wave * 16384);
    constexpr int I_IN = 16 * 48, I_OUT = 16 * 32, I_G = 16 * 88, I_D = 44 * 32;
    const int total = set == 0 ? 2 * I_IN + I_OUT : set == 1 ? 2 * I_G + I_D + I_OUT : 2 * I_G + I_D;
    for (int it = widx; it < total; it += nw) {
        int r = it, kind, l;
        if (set == 0) { if (r < 2 * I_IN) { kind = 0; l = r / I_IN; r %= I_IN; } else { kind = 1; l = 0; r -= 2 * I_IN; } }
        else { l = set - 1; if (r < 2 * I_G) kind = 2; else if (r < 2 * I_G + I_D) { kind = 3; r -= 2 * I_G; } else { kind = 1; l = 1; r -= 2 * I_G + I_D; } }
        if (kind == 0) { const int kb = r / 48, nb = r % 48; p0_transpose_item(A.in[8] + (size_t)l * 1024 * INW, 1024, INW, (bf16*)(F.ws + WS_WIN) + (size_t)l * INW * 1024, 64 * kb, 32 * nb, 32 * nb, scr, F.lane); }
        else if (kind == 1) { const int kb = r / 32, nb = r % 32; p0_transpose_item(A.in[16] + (size_t)l * 1024 * 1024, 1024, 1024, (bf16*)(F.ws + WS_WOUT) + (size_t)l * 1024 * 1024, 64 * kb, 32 * nb, 32 * nb, scr, F.lane); }
        else if (kind == 2) { const int up = r >= I_G; if (up) r -= I_G; const int kb = r / 88, nb = r % 88, n0 = 32 * nb;
            p0_transpose_item(A.in[up ? 18 : 17] + (size_t)l * 1024 * FF, 1024, FF, (bf16*)(F.ws + WS_WGU) + (size_t)l * 2 * FF * 1024, 64 * kb, n0, 256 * (n0 >> 7) + (n0 & 127) + (up ? 128 : 0), scr, F.lane); }
        else { const int kb = r / 32, nb = r % 32; p0_transpose_item(A.in[19] + (size_t)l * FF * 1024, FF, 1024, (bf16*)(F.ws + WS_WDN) + (size_t)l * 1024 * FF, 64 * kb, 32 * nb, 32 * nb, scr, F.lane); }
    }
}
__device__ __forceinline__ void tail_transposes(const Args& A, Frame& F, int set, int nwg) {
    relaunder(F);
    const int G = F.G, rounds = (nwg + G - 1) / G; int first_idle = nwg - G * (rounds - 1); if (first_idle >= G) first_idle = 0;
    if ((int)blockIdx.x >= first_idle) transpose_set(A, F, set, ((int)blockIdx.x - first_idle) * NWAVES + F.wave, (G - first_idle) * NWAVES);
}
__device__ __forceinline__ void p0_prologue(const Args& A, Frame& F) {
    relaunder(F);
    const int gw = F.vcu * NWAVES + F.wave, NGW = F.G * NWAVES;
    const int gt = F.vcu * NTHR + F.tid, NGT = F.G * NTHR;
    LAS float* S = (LAS float*)F.lds;
    {   f32x4 cv[5];
#pragma unroll
        for (int i = 0; i < 5; ++i) { const int q = min(F.tid + NTHR * i, 2303); cv[i] = q < 2048 ? *(const f32x4*)(A.in[1] + 4 * q) : *(const f32x4*)(A.in[3] + 4 * (q - 2048)); }
#pragma unroll
        for (int i = 0; i < 5; ++i) { const int q = F.tid + NTHR * i; if (q < 2304) { f32x4 o;
#pragma unroll
            for (int e = 0; e < 4; ++e) o[e] = cv[i][e] * __builtin_amdgcn_rcpf(1.0f + __builtin_amdgcn_exp2f(cv[i][e] * -1.4426950408889634f));
            *(LAS f32x4*)(S + 4 * q) = o; } }
    }
    __syncthreads();
    float* mod = (float*)(F.ws + WS_MOD);
    constexpr int MOD_KS = 16, MOD_KL = 1024 / MOD_KS, MOD_ITEMS = DEPTH * (MODW / 64) * MOD_KS;
    for (int it = gw; it < MOD_ITEMS; it += NGW) {
        const int ks = it % MOD_KS, cgp = (it / MOD_KS) % (MODW / 64), l = it / (MOD_KS * (MODW / 64));
        const int n = cgp * 64 + F.lane, k0 = ks * MOD_KL;
        const float* wp = A.in[4] + (size_t)l * 1024 * MODW + (size_t)k0 * MODW + n;
        float a[9];
#pragma unroll
        for (int r = 0; r < 9; ++r) a[r] = 0.f;
#pragma unroll 16
        for (int kk = 0; kk < MOD_KL; ++kk) { const float w = __builtin_nontemporal_load(&wp[(size_t)kk * MODW]);
#pragma unroll
            for (int r = 0; r < 9; ++r) a[r] += S[r * 1024 + k0 + kk] * w; }
        if (ks == 0) { const float bv = A.in[5][l * MODW + n];
#pragma unroll
            for (int r = 0; r < 9; ++r) a[r] += bv; }
#pragma unroll
        for (int r = 0; r < 9; ++r) atomicAdd(mod + ((size_t)l * 9 + r) * MODW + n, a[r]);
    }
    __syncthreads();
    float* rc = (float*)(F.ws + WS_ROPE); float* rs = rc + SEQ * 32;
    for (int i = gt; i < SEQ * 32; i += NGT) { const int tok = i >> 5, p = i & 31; const float pos = (float)(p < 16 ? (tok >> 6) : (tok & 63));
        const float inv = exp2f(-(float)(p & 15) * (13.287712379549449f / 16.0f));
        const float ang = pos * inv; const float nrev = rintf(ang * 0.15915494309189535f);
        float r = fmaf(-nrev, 6.2831855f, ang); r = fmaf(-nrev, -1.7484555e-7f, r);
        rc[i] = __cosf(r); rs[i] = __sinf(r); }
    bf16* wsb = (bf16*)(F.ws + WS_WS);
    for (int i = gt; i < DEPTH * 4 * 128 * 128; i += NGT) wsb[i] = (bf16)f2bf(A.in[12][i]);
    bf16* pwb = (bf16*)(F.ws + WS_PW);
    for (int i = gt; i < DEPTH * 4 * 64 * 64; i += NGT) { const int c = i & 63, d = (i >> 6) & 63, lg = i >> 12; pwb[i] = (bf16)f2bf(A.in[14][(size_t)lg * 4096 + c * 64 + d]); }
    transpose_set(A, F, 0, gw, NGW);
}

__device__ __forceinline__ void norm_phase(Frame& F, const float* lat, const float* ctx, int nrows, const float* g, const float* modl, int sc_off, bf16* H, float* rss) {
    relaunder(F);
    const int gw = F.vcu * NWAVES + F.wave, NGW = F.G * NWAVES;
    for (int row = gw; row < nrows; row += NGW) {
        const bool isl = row < NLAT; const int b = isl ? (row >> 11) : 8;
        const f32x4* xr = (const f32x4*)(isl ? lat + (size_t)row * DMODEL : ctx + (size_t)(row - NLAT) * DMODEL) + F.lane;
        f32x4 v[4]; float s = 0.f;
#pragma unroll
        for (int j = 0; j < 4; ++j) { v[j] = xr[64 * j]; s += (v[j].x * v[j].x + v[j].y * v[j].y) + (v[j].z * v[j].z + v[j].w * v[j].w); }
        s = wave_sum(s);
        if (F.lane == 0) rss[row] = s;
        const f32x4* g4 = (const f32x4*)g + F.lane; const f32x4* sc4 = (const f32x4*)(modl + (size_t)b * MODW + sc_off) + F.lane;
        v2u* o8 = (v2u*)(H + (size_t)row * DMODEL) + F.lane;
#pragma unroll
        for (int j = 0; j < 4; ++j) { const f32x4 y = v[j] * g4[64 * j] * (sc4[64 * j] + 1.0f); v2u o; o.x = pk2(y.x, y.y); o.y = pk2(y.z, y.w); o8[64 * j] = o; }
    }
}
__device__ __forceinline__ void ctx_combine_phase(Frame& F, const float* slabs, const float* base_ctx, float* out_ctx, const float* gate, const float* gn, const float* scn, bf16* H, float* rss) {
    relaunder(F);
    const int gw = F.vcu * NWAVES + F.wave, NGW = F.G * NWAVES, lane = F.lane;
    for (int R = gw; R < NCTX; R += NGW) {
        const int pmc = R >> 8, r = R & 255;
        f32x4 sv[4][KSPLIT], bv[4];
#pragma unroll
        for (int j = 0; j < 4; ++j) { bv[j] = *(const f32x4*)(base_ctx + (size_t)R * DMODEL + 256 * j + 4 * lane);
#pragma unroll
            for (int q = 0; q < KSPLIT; ++q) sv[j][q] = *(const f32x4*)(slabs + (size_t)((j * 8 + pmc) * KSPLIT + q) * 65536 + (size_t)r * 256 + 4 * lane); }
        float ss = 0.f; f32x4 x[4];
#pragma unroll
        for (int j = 0; j < 4; ++j) { f32x4 a = sv[j][0];
#pragma unroll
            for (int q = 1; q < KSPLIT; ++q) a += sv[j][q];
            x[j] = bv[j] + *(const f32x4*)(gate + 8 * MODW + 256 * j + 4 * lane) * a;
            ss += (x[j].x * x[j].x + x[j].y * x[j].y) + (x[j].z * x[j].z + x[j].w * x[j].w); }
        ss = wave_sum(ss);
        if (lane == 0) rss[NLAT + R] = ss;
#pragma unroll
        for (int j = 0; j < 4; ++j) { const int c = 256 * j + 4 * lane; *(f32x4*)(out_ctx + (size_t)R * DMODEL + c) = x[j];
            const f32x4 y = x[j] * *(const f32x4*)(gn + c) * (*(const f32x4*)(scn + 8 * MODW + c) + 1.0f); v2u o; o.x = pk2(y.x, y.y); o.y = pk2(y.z, y.w); *(v2u*)(H + (size_t)(NLAT + R) * DMODEL + c) = o; }
    }
}
__device__ __forceinline__ void bias_phase(Frame& F, const float* mod, int sel) {
    relaunder(F);
    LAS bf16* S = (LAS bf16*)F.lds;
    constexpr int SP = 1032;
    {
        f32x4 tv[18];
#pragma unroll
        for (int i = 0; i < 18; ++i) { const int q = F.tid + NTHR * i, row = q >> 8, c4 = q & 255, tb = row / 9, r = row % 9;
            tv[i] = *(const f32x4*)(mod + (size_t)(tb >> 1) * 9 * MODW + (size_t)r * MODW + ((tb & 1) ? 3072 : 0) + 4 * c4); }
#pragma unroll
        for (int i = 0; i < 18; ++i) { const int q = F.tid + NTHR * i, row = q >> 8, c4 = q & 255, tb = row / 9, r = row % 9;
            v2u o; o.x = pk2(tv[i].x, tv[i].y); o.y = pk2(tv[i].z, tv[i].w); *(LAS v2u*)(S + (tb * 10 + r) * SP + 4 * c4) = o; }
#pragma unroll
        for (int i = 0; i < 2; ++i) { const int q = F.tid + NTHR * i, tb = q >> 8, c4 = q & 255; *(LAS v2u*)(S + (tb * 10 + 9) * SP + 4 * c4) = (v2u){0u, 0u}; }
    }
    __syncthreads();
    const int gw = F.vcu * NWAVES + F.wave, NGW = F.G * NWAVES, lane = F.lane, fr = lane & 15, fq = lane >> 4;
    constexpr int IT_IN = INW / 16, IT_GU = 2 * FF / 16;
    const int nit = sel < 0 ? DEPTH * IT_IN : IT_GU;
    for (int it = gw; it < nit; it += NGW) {
        const int gu = sel >= 0, l = gu ? sel : it / IT_IN; int r = gu ? it : it % IT_IN; const int NR = gu ? 2 * FF : INW;
        const bf16* Wt = (gu ? (const bf16*)(F.ws + WS_WGU) + (size_t)l * 2 * FF * 1024 : (const bf16*)(F.ws + WS_WIN) + (size_t)l * INW * 1024) + (size_t)(16 * r + fr) * 1024 + 8 * fq;
        const LAS bf16* Sp = S + ((l * 2 + gu) * 10 + (fr < 9 ? fr : 9)) * SP + 8 * fq;
        f32x4 acc = (f32x4){0.f, 0.f, 0.f, 0.f};
#pragma unroll 8
        for (int kk = 0; kk < 32; ++kk) { const bf16x8 a = *(const LAS bf16x8*)(Sp + 32 * kk); const bf16x8 bfr = *(const bf16x8*)(Wt + 32 * kk); acc = __builtin_amdgcn_mfma_f32_16x16x32_bf16(a, bfr, acc, 0, 0, 0); }
        float* bo = (float*)(F.ws + WS_BIAS) + (gu ? (size_t)DEPTH * 9 * INW + (size_t)l * 9 * 2 * FF : (size_t)l * 9 * INW);
#pragma unroll
        for (int i = 0; i < 4; ++i) { const int rr = 4 * fq + i; if (rr < 9) bo[(size_t)rr * NR + 16 * r + fr] = acc[i]; }
    }
    __syncthreads();
}
__device__ __forceinline__ void final_norm_phase(Frame& F, const unsigned short* xh, float* out, const float* g) {
    relaunder(F);
    const int gw = F.vcu * NWAVES + F.wave, NGW = F.G * NWAVES;
    for (int row = gw; row < NLAT; row += NGW) {
        f32x4 v[4];
#pragma unroll
        for (int j = 0; j < 2; ++j) { const v4u w = *(const v4u*)(xh + (size_t)row * DMODEL + 512 * j + 8 * F.lane); pg8::unpack_h8(w, v[2 * j], v[2 * j + 1]); }
        float s = 0.f;
#pragma unroll
        for (int j = 0; j < 4; ++j) s += (v[j].x * v[j].x + v[j].y * v[j].y) + (v[j].z * v[j].z + v[j].w * v[j].w);
        const float rstd = 1.0f / sqrtf(wave_sum(s) * (1.f / DMODEL) + EPS);
#pragma unroll
        for (int j = 0; j < 2; ++j) { const int c = 512 * j + 8 * F.lane; float* o = out + (size_t)row * DMODEL + c;
            *(f32x4*)o = (v[2 * j] * rstd) * *(const f32x4*)(g + c); *(f32x4*)(o + 4) = (v[2 * j + 1] * rstd) * *(const f32x4*)(g + c + 4); }
    }
}

__device__ __forceinline__ void prep_qkv(const Args& A, Frame& F, int l, const bf16* Z, bf16* MIX, bf16* KB, bf16* VB) {
    relaunder(F);
    const int gw = F.vcu * NWAVES + F.wave, NGW = F.G * NWAVES, lane = F.lane;
    const float* rc = (const float*)(F.ws + WS_ROPE); const float* rs = rc + SEQ * 32;
    const int j = lane & 7;
    float qn_[8], kn_[8];
#pragma unroll
    for (int e = 0; e < 8; ++e) { qn_[e] = A.in[9][l * 64 + 8 * j + e]; kn_[e] = A.in[10][l * 64 + 8 * j + e]; }
    const float sgn = (j < 4) ? -1.f : 1.f;
    for (int rowb = gw; rowb < MT; rowb += 3 * NGW) {
        v4u rq[3], rk[3]; f32x4 c0[3], c1[3], s0[3], s1[3];
#pragma unroll
        for (int q = 0; q < 3; ++q) { const int row = min(rowb + q * NGW, MT - 1); const bool isl = row < NLAT; const int t = isl ? (row & 2047) : 0;
            const bf16* zr = Z + (size_t)row * INW;
            rq[q] = *(const v4u*)(zr + 8 * lane); rk[q] = *(const v4u*)(zr + O_K + 8 * (lane & 31));
            const f32x4* c4 = (const f32x4*)(rc + t * 32 + 8 * (j & 3)); const f32x4* s4 = (const f32x4*)(rs + t * 32 + 8 * (j & 3));
            c0[q] = c4[0]; c1[q] = c4[1]; s0[q] = s4[0]; s1[q] = s4[1]; }
#pragma unroll
        for (int q = 0; q < 3; ++q) { const int row = rowb + q * NGW; if (row < MT) {
            const bool isl = row < NLAT; const int b = isl ? (row >> 11) : ((row - NLAT) >> 8); const int t = isl ? (row & 2047) : ((row - NLAT) & 255);
            float cs[8], sn[8];
            cs[0] = c0[q].x; cs[1] = c0[q].y; cs[2] = c0[q].z; cs[3] = c0[q].w; cs[4] = c1[q].x; cs[5] = c1[q].y; cs[6] = c1[q].z; cs[7] = c1[q].w;
            sn[0] = s0[q].x; sn[1] = s0[q].y; sn[2] = s0[q].z; sn[3] = s0[q].w; sn[4] = s1[q].x; sn[5] = s1[q].y; sn[6] = s1[q].z; sn[7] = s1[q].w;
            if (!isl) {
#pragma unroll
                for (int e = 0; e < 8; ++e) { cs[e] = 1.f; sn[e] = 0.f; } }
            { float f[8]; unpack8(rq[q], f); float ss = 0.f;
#pragma unroll
                for (int e = 0; e < 8; ++e) ss += f[e] * f[e];
                ss += __shfl_xor(ss, 1); ss += __shfl_xor(ss, 2); ss += __shfl_xor(ss, 4);
                const float rstd = 1.0f / sqrtf(ss * (1.f / 64.f) + EPS);
                float o[8];
#pragma unroll
                for (int e = 0; e < 8; ++e) { const float a = f[e] * rstd * qn_[e]; const float pv = __shfl_xor(a, 4); o[e] = (a * cs[e] + sgn * pv * sn[e]) * attn_body::C2; }
                *(v4u*)(MIX + (size_t)row * 1024 + 8 * lane) = pack8(o); }
            { float f[8]; unpack8(rk[q], f); float ss = 0.f;
#pragma unroll
                for (int e = 0; e < 8; ++e) ss += f[e] * f[e];
                ss += __shfl_xor(ss, 1); ss += __shfl_xor(ss, 2); ss += __shfl_xor(ss, 4);
                const float rstd = 1.0f / sqrtf(ss * (1.f / 64.f) + EPS);
                float o[8];
#pragma unroll
                for (int e = 0; e < 8; ++e) { const float a = f[e] * rstd * kn_[e]; const float pv = __shfl_xor(a, 4); o[e] = a * cs[e] + sgn * pv * sn[e]; }
                const size_t krow = ((size_t)b * NKEY + (isl ? CTXL + t : t)) * KVW;
                if (lane < 16) *(v4u*)(KB + krow + 8 * lane) = pack8(o);
                else if (lane < 32) *(v4u*)(VB + krow + 8 * (lane - 16)) = rk[q]; } } }
    }
}
__device__ __forceinline__ void sgu_item(const Args& A, Frame& F, int l, int ci, int hg, const bf16* Z, bf16* MIX, const float* rssv) {
    relaunder(F);
    const int tid = F.tid, lane = F.lane, wave = F.wave, fr = lane & 15, fq = lane >> 4;
    LAS bf16* vT = (LAS bf16*)F.lds;
    LAS float* U = (LAS float*)(F.lds + 17408);
    LAS bf16* OUT = (LAS bf16*)(F.lds + 17408 + 34816);
    const int row0 = ci * 128;
    const int r = tid >> 2, qd = tid & 3; const bf16* zr = Z + (size_t)(row0 + r) * INW + O_G;
    v4u vg[2], uu[2];
#pragma unroll
    for (int i = 0; i < 2; ++i) { vg[i] = *(const v4u*)(zr + 256 + 64 * hg + 16 * qd + 8 * i); uu[i] = *(const v4u*)(zr + 64 * hg + 16 * qd + 8 * i); }
    const float ssv = rssv[row0 + r];
    const bf16* wsb = (const bf16*)(F.ws + WS_WS) + ((size_t)(l * 4 + hg) * 128 + 16 * wave + fr) * 128 + 8 * fq;
    bf16x8 af[4];
#pragma unroll
    for (int kk = 0; kk < 4; ++kk) af[kk] = *(const bf16x8*)(wsb + 32 * kk);
    const float* gn = A.in[11] + l * 256 + 64 * hg + 16 * qd;
    float gnv[16];
#pragma unroll
    for (int e = 0; e < 16; ++e) gnv[e] = gn[e];
    const float* bs = A.in[13] + (size_t)(l * 4 + hg) * 128 + 16 * wave + 4 * fq;
    float bsv[4];
#pragma unroll
    for (int i = 0; i < 4; ++i) bsv[i] = bs[i];
    {   const float rstd = 1.0f / sqrtf(ssv * (1.f / 256.f) + EPS);
#pragma unroll
        for (int i = 0; i < 2; ++i) { float f[8]; unpack8(vg[i], f);
#pragma unroll
            for (int e = 0; e < 8; ++e) vT[(16 * qd + 8 * i + e) * 136 + r] = (bf16)f2bf(f[e] * rstd * gnv[8 * i + e]); }
#pragma unroll
        for (int i = 0; i < 2; ++i) { float f[8]; unpack8(uu[i], f);
            *(LAS f32x4*)(U + r * 68 + 16 * qd + 8 * i) = (f32x4){f[0], f[1], f[2], f[3]};
            *(LAS f32x4*)(U + r * 68 + 16 * qd + 8 * i + 4) = (f32x4){f[4], f[5], f[6], f[7]}; }
    }
    __syncthreads();
    {   f32x4 acc[4];
#pragma unroll
        for (int n = 0; n < 4; ++n) acc[n] = (f32x4){0.f, 0.f, 0.f, 0.f};
#pragma unroll
        for (int kk = 0; kk < 4; ++kk)
#pragma unroll
            for (int n = 0; n < 4; ++n) { const bf16x8 bfr = *(const LAS bf16x8*)(vT + (16 * n + fr) * 136 + 32 * kk + 8 * fq); acc[n] = __builtin_amdgcn_mfma_f32_16x16x32_bf16(af[kk], bfr, acc[n], 0, 0, 0); }
#pragma unroll
        for (int i = 0; i < 4; ++i) { const int p = 16 * wave + 4 * fq + i;
#pragma unroll
            for (int n = 0; n < 4; ++n) OUT[p * 72 + 16 * n + fr] = (bf16)f2bf(U[p * 68 + 16 * n + fr] * (acc[n][i] + bsv[i])); }
    }
    __syncthreads();
    {   const int p = tid >> 2, c = (tid & 3) * 16;
        const v4u o0 = *(const LAS v4u*)(OUT + p * 72 + c), o1 = *(const LAS v4u*)(OUT + p * 72 + c + 8);
        bf16* dst = MIX + (size_t)(row0 + p) * 1024 + 512 + 64 * hg + c; *(v4u*)dst = o0; *(v4u*)(dst + 8) = o1; }
    __syncthreads();
}
template <int G> __device__ __forceinline__ void pool_item(const Args& A, Frame& F, int l, int ci, const bf16* Z, bf16* MIX) {
    relaunder(F);
    constexpr int W = 2 << G, HALFW = W / 2;
    const int tid = F.tid, lane = F.lane, wave = F.wave, fr = lane & 15, fq = lane >> 4;
    LAS bf16* Dm = (LAS bf16*)F.lds;
    LAS bf16* OUT = (LAS bf16*)(F.lds + 18432);
    const int row0 = ci * 128;
    const int seq0 = ci < 128 ? (ci >> 4) * SEQ : NLAT + ((ci - 128) >> 1) * CTXL, N = ci < 128 ? SEQ : CTXL;
    const bf16* pwb = (const bf16*)(F.ws + WS_PW) + (size_t)(l * 4 + G) * 4096;
    float psc[4];
#pragma unroll
    for (int n = 0; n < 4; ++n) psc[n] = A.in[15][l * 256 + 64 * G + 16 * n + fr];
    {   const int r = tid >> 2, qd = tid & 3; const int t = row0 + r - seq0;
        const bf16* zc = Z + (size_t)seq0 * INW + O_P + 64 * G + 16 * qd;
        float sum[16], pc[16];
#pragma unroll
        for (int e = 0; e < 16; ++e) { sum[e] = 0.f; pc[e] = 0.f; }
        constexpr int BT = W < 8 ? W : 8;
#pragma unroll
        for (int j0 = 0; j0 < W; j0 += BT) {
            v4u ra[BT], rb[BT];
#pragma unroll
            for (int jj = 0; jj < BT; ++jj) { const int tj = t - HALFW + j0 + jj; const int tc = min(max(tj, 0), N - 1); ra[jj] = *(const v4u*)(zc + (size_t)tc * INW); rb[jj] = *(const v4u*)(zc + (size_t)tc * INW + 8); }
#pragma unroll
            for (int jj = 0; jj < BT; ++jj) { const int tj = t - HALFW + j0 + jj; const float wgt = (tj >= 0 && tj < N) ? 1.f : 0.f; float f0[8], f1[8]; unpack8(ra[jj], f0); unpack8(rb[jj], f1);
#pragma unroll
                for (int e = 0; e < 8; ++e) { sum[e] += wgt * f0[e]; sum[8 + e] += wgt * f1[e]; if (j0 + jj == HALFW) { pc[e] = f0[e]; pc[8 + e] = f1[e]; } } }
        }
        const int lo = max(t - HALFW, 0), hi = min(t - HALFW + W, N);
        const float rcnt = 1.0f / (float)(hi - lo);
        float d0[8], d1[8];
#pragma unroll
        for (int e = 0; e < 8; ++e) { d0[e] = sum[e] * rcnt - pc[e]; d1[e] = sum[8 + e] * rcnt - pc[8 + e]; }
        *(LAS v4u*)(Dm + r * 72 + 16 * qd) = pack8(d0); *(LAS v4u*)(Dm + r * 72 + 16 * qd + 8) = pack8(d1);
    }
    bf16x8 bfr[2][4];
#pragma unroll
    for (int kk = 0; kk < 2; ++kk)
#pragma unroll
        for (int n = 0; n < 4; ++n) bfr[kk][n] = *(const bf16x8*)(pwb + (16 * n + fr) * 64 + 32 * kk + 8 * fq);
    __syncthreads();
    {   f32x4 acc[4];
#pragma unroll
        for (int n = 0; n < 4; ++n) acc[n] = (f32x4){0.f, 0.f, 0.f, 0.f};
#pragma unroll
        for (int kk = 0; kk < 2; ++kk) { const bf16x8 a = *(const LAS bf16x8*)(Dm + (16 * wave + fr) * 72 + 32 * kk + 8 * fq);
#pragma unroll
            for (int n = 0; n < 4; ++n) acc[n] = __builtin_amdgcn_mfma_f32_16x16x32_bf16(a, bfr[kk][n], acc[n], 0, 0, 0); }
#pragma unroll
        for (int n = 0; n < 4; ++n)
#pragma unroll
            for (int i = 0; i < 4; ++i) OUT[(16 * wave + 4 * fq + i) * 72 + 16 * n + fr] = (bf16)f2bf(acc[n][i] * psc[n]);
    }
    __syncthreads();
    {   const int p = tid >> 2, c = (tid & 3) * 16;
        const v4u o0 = *(const LAS v4u*)(OUT + p * 72 + c), o1 = *(const LAS v4u*)(OUT + p * 72 + c + 8);
        bf16* dst = MIX + (size_t)(row0 + p) * 1024 + 768 + 64 * G + c; *(v4u*)dst = o0; *(v4u*)(dst + 8) = o1; }
    __syncthreads();
}
__device__ __forceinline__ void prep_phase(const Args& A, Frame& F, int l, const bf16* Z, bf16* MIX, bf16* KB, bf16* VB) {
    prep_qkv(A, F, l, Z, MIX, KB, VB);
    const int NCH = (l + 1 < DEPTH) ? MT / 128 : NLAT / 128;
    unsigned* ctr = (unsigned*)(F.ws + WS_CTL) + 64 * (8 + l);
    volatile LAS unsigned* tk = (volatile LAS unsigned*)(F.lds + MISC_OFF) + 16;
    for (;;) {
        relaunder(F);
        if (F.tid == 0) tk[0] = atomicAdd(ctr, 1u);
        __syncthreads();
        const unsigned it = tk[0];
        __syncthreads();
        if (it >= (unsigned)(NCH * 8)) break;
        const int ord = (int)(it / NCH), ci = (int)(it % NCH);
        const int k = ord == 0 ? 7 : ord == 1 ? 6 : ord < 6 ? ord - 2 : ord == 6 ? 5 : 4;
        if (k < 4) sgu_item(A, F, l, ci, k, Z, MIX, (const float*)(F.ws + WS_RSSV) + (size_t)l * MT);
        else if (k == 4) pool_item<0>(A, F, l, ci, Z, MIX); else if (k == 5) pool_item<1>(A, F, l, ci, Z, MIX); else if (k == 6) pool_item<2>(A, F, l, ci, Z, MIX); else pool_item<3>(A, F, l, ci, Z, MIX);
    }
    bias_phase(F, (const float*)(F.ws + WS_MOD), l);
}

__device__ __forceinline__ void attention_phase(Frame& F, int l, char* lds, bf16* MIX, const bf16* KB, const bf16* VB) {
    const int nunits = (l == 0) ? 576 : 512;
    for (int i = 0;; ++i) {
        const int u = F.vcu + i * F.G; if (u >= nunits) break;
        const attn_body::bf16 *q, *k, *v; int NT;
        if (u < 512) { const int b = (u & 255) >> 5, r = (u & 31) + 32 * (u >> 8), h = r >> 3, qb = r & 7;
            q = (const attn_body::bf16*)MIX + ((size_t)b * SEQ + qb * 256) * 1024 + h * 64; k = (const attn_body::bf16*)KB + (size_t)b * NKEY * KVW + (h >> 2) * 64; v = (const attn_body::bf16*)VB + (size_t)b * NKEY * KVW + (h >> 2) * 64; NT = NKEY / 64; }
        else { const int c = u - 512, b = c >> 3, h = c & 7;
            q = (const attn_body::bf16*)MIX + ((size_t)NLAT + b * CTXL) * 1024 + h * 64; k = (const attn_body::bf16*)KB + (size_t)b * NKEY * KVW + (h >> 2) * 64; v = (const attn_body::bf16*)VB + (size_t)b * NKEY * KVW + (h >> 2) * 64; NT = CTXL / 64; }
        attn_body::attn_unit<8>(q, k, v, (attn_body::bf16*)q, NT, lds);
    }
}

__global__ void __launch_bounds__(NTHR, 2) fwd_megakernel(const Args args) {
    const Args& A = args;
    extern __shared__ __attribute__((aligned(16))) unsigned char lds[];
    Frame F;
    F.lds = (LAS unsigned char*)lds;
    relaunder(F);
    for (int u = threadIdx.x; u < (LDS_BYTES - LDSCTL_OFF) / 4; u += NTHR) ((LAS unsigned*)((LAS unsigned char*)lds + LDSCTL_OFF))[u] = 0u;
    __syncthreads();
    (void)xcd_barrier_post((unsigned*)(args.ws + WS_CTL) + CW_BAR, (volatile LAS unsigned*)((LAS unsigned char*)lds + MISC_OFF) + 8);
#define GRID_BAR() do { __attribute__((address_space(1))) unsigned* bp_ = (__attribute__((address_space(1))) unsigned*)((unsigned*)(args.ws + WS_CTL) + CW_BAR); asm volatile("" : "+s"(bp_)); XcdBarrier b_; b_.bar = (unsigned*)bp_; b_.x = xb_xcc_id(); b_.st = (volatile LAS unsigned*)((LAS unsigned char*)lds + MISC_OFF) + 8; xcd_barrier(b_); } while (0)
    F.G = gridDim.x; { const int bx = blockIdx.x; F.vcu = (F.G % 8 == 0) ? (bx % 8) * (F.G / 8) + bx / 8 : bx; }
    F.out = args.out; F.ws = args.ws;
#define GASP __attribute__((address_space(1)))
#define WSL() ({ GASP unsigned char* w_ = (GASP unsigned char*)args.ws; asm volatile("" : "+s"(w_)); (unsigned char*)w_; })
#define P_H ((bf16*)(WSL() + WS_H))
#define P_Z ((bf16*)(WSL() + WS_Z))
#define P_MIX ((bf16*)(WSL() + WS_MIX))
#define P_KB ((bf16*)(WSL() + WS_KB))
#define P_VB ((bf16*)(WSL() + WS_VB))
#define P_ACT ((bf16*)(WSL() + WS_ACT))
#define P_CTXRES ((float*)(WSL() + WS_CTXRES))
#define P_XRES ({ GASP float* o_ = (GASP float*)args.out; asm volatile("" : "+s"(o_)); (float*)o_; })
#define P_MOD ((const float*)(WSL() + WS_MOD))
#define P_RSS ((float*)(WSL() + WS_RSS))
#define P_BIASIN ((const float*)(WSL() + WS_BIAS))
#define P_BIASGU ((const float*)(WSL() + WS_BIAS) + (size_t)DEPTH * 9 * INW)
#define P_SLABS ((float*)(WSL() + WS_SLAB))
#define P_XH ((unsigned short*)(WSL() + WS_XH))

    p0_prologue(args, F);
    GRID_BAR();
    norm_phase(F, A.in[0], A.in[2], MT, A.in[6], P_MOD, 1024, P_H, P_RSS + 3 * MT);
    bias_phase(F, P_MOD, -1);
    GRID_BAR();
    {
        const int Mrows = (0 == 0) ? MT : NLAT;
        {   pg8::Gemm g{P_H, (const bf16*)(WSL() + WS_WIN) + (size_t)0 * INW * 1024, MT, INW, 1024}; pg8::StaticOrder S; S.init(MT, INW, F.G, (int)blockIdx.x);
            pg8::EpiStoreBf16 E{P_Z, INW, P_RSS + (0 == 0 ? 3 : 1) * MT, P_BIASIN + (size_t)0 * 9 * INW, INW, F.lds, (float*)(WSL() + WS_RSSV) + (size_t)0 * MT};
            pg8::gemm_phase<pg8::EpiStoreBf16, pg8::StaticOrder, true, true>(F.lds, g, S, E); }
        tail_transposes(args, F, 1, (MT / 256) * (INW / 256));
        GRID_BAR();
        prep_phase(args, F, 0, P_Z, P_MIX, P_KB, P_VB);
        GRID_BAR();
        attention_phase(F, 0, (char*)lds, P_MIX, P_KB, P_VB);
        GRID_BAR();
        {   pg8::Gemm g{P_MIX, (const bf16*)(WSL() + WS_WOUT) + (size_t)0 * 1024 * 1024, Mrows, 1024, 1024};
            pg8::EpiResid<true> E{A.in[0], P_XH, (P_MOD + (size_t)0 * 9 * MODW) + 2048, A.in[7] + 0 * DMODEL, (P_MOD + (size_t)0 * 9 * MODW) + 4096, P_H, P_RSS + (0 == 0 ? 0 : 2) * MT};
            if (0 == 0) { pg8::SliceOrder S2; S2.init(1024, KSPLIT, F.G, (int)blockIdx.x); pg8::EpiSlab E2{P_SLABS}; pg8::gemm_phase<pg8::EpiSlab, pg8::SliceOrder, true, true>(F.lds, g, S2, E2); }
            pg8::StaticOrder S; S.init(NLAT, 1024, F.G, (int)blockIdx.x); pg8::gemm_phase<pg8::EpiResid<true>, pg8::StaticOrder, false, true>(F.lds, g, S, E); }
        GRID_BAR();
        if (0 == 0) { ctx_combine_phase(F, P_SLABS, ((0 == 0) ? A.in[2] : (const float*)P_CTXRES), P_CTXRES, (P_MOD + (size_t)0 * 9 * MODW) + 2048, A.in[7] + 0 * DMODEL, (P_MOD + (size_t)0 * 9 * MODW) + 4096, P_H, P_RSS + 0 * MT); GRID_BAR(); }
        {   pg8::Gemm g{P_H, (const bf16*)(WSL() + WS_WGU) + (size_t)0 * 2 * FF * 1024, Mrows, 2 * FF, 1024}; pg8::CtxFirstOrder S; S.init(2 * FF, F.G, (int)blockIdx.x);
            unsigned* ctx_done = (unsigned*)(WSL() + WS_CTL) + 64 * 11;
            pg8::EpiSwiGLU E{P_ACT, FF, P_RSS + (0 == 0 ? 0 : 2) * MT, P_BIASGU + (size_t)0 * 9 * 2 * FF, 2 * FF, F.lds, ctx_done};
            pg8::gemm_phase<pg8::EpiSwiGLU, pg8::CtxFirstOrder, true, true>(F.lds, g, S, E);
            {   const int nwg = (MT / 256) * (2 * FF / 256), G = F.G, rounds = (nwg + G - 1) / G; int first_idle = nwg - G * (rounds - 1); if (first_idle >= G) first_idle = 0;
                if ((int)blockIdx.x >= first_idle) {
                    if (threadIdx.x == 0) { unsigned sp = 0;
                        while (__hip_atomic_load(ctx_done, __ATOMIC_RELAXED, __HIP_MEMORY_SCOPE_AGENT) < 8u * (2 * FF / 256)) { __builtin_amdgcn_s_sleep(2); if (++sp > (1u << 20)) break; }
                        __builtin_amdgcn_fence(__ATOMIC_ACQUIRE, "agent"); asm volatile("s_waitcnt vmcnt(0)" ::: "memory"); }
                    __syncthreads();
                    pg8::Gemm g2{P_ACT, (const bf16*)(WSL() + WS_WDN) + (size_t)0 * 1024 * FF, Mrows, 1024, FF};
                    pg8::SliceOrder S2; S2.init(FF, KSPLIT, G - first_idle, (int)blockIdx.x - first_idle); pg8::EpiSlab E2{P_SLABS};
                    pg8::gemm_phase<pg8::EpiSlab, pg8::SliceOrder, true, true>(F.lds, g2, S2, E2); } } }
        GRID_BAR();
        ctx_combine_phase(F, P_SLABS, P_CTXRES, P_CTXRES, (P_MOD + (size_t)0 * 9 * MODW) + 5120, A.in[6] + 1 * DMODEL, P_MOD + (size_t)1 * 9 * MODW + 1024, P_H, P_RSS + 1 * MT);
        {   pg8::Gemm g{P_ACT, (const bf16*)(WSL() + WS_WDN) + (size_t)0 * 1024 * FF, Mrows, 1024, FF}; pg8::StaticOrder S; S.init(NLAT, 1024, F.G, (int)blockIdx.x);
            const int nl = (0 + 1 < DEPTH) ? 0 + 1 : 0;
            pg8::EpiResid<false> E{P_XH, P_XH, (P_MOD + (size_t)0 * 9 * MODW) + 5120, A.in[6] + nl * DMODEL, P_MOD + (size_t)nl * 9 * MODW + 1024, P_H, P_RSS + 1 * MT};
            pg8::gemm_phase<pg8::EpiResid<false>, pg8::StaticOrder, false, true>(F.lds, g, S, E); }
        GRID_BAR();
    }
    {
        const int Mrows = (1 == 0) ? MT : NLAT;
        {   pg8::Gemm g{P_H, (const bf16*)(WSL() + WS_WIN) + (size_t)1 * INW * 1024, MT, INW, 1024}; pg8::StaticOrder S; S.init(MT, INW, F.G, (int)blockIdx.x);
            pg8::EpiStoreBf16 E{P_Z, INW, P_RSS + (1 == 0 ? 3 : 1) * MT, P_BIASIN + (size_t)1 * 9 * INW, INW, F.lds, (float*)(WSL() + WS_RSSV) + (size_t)1 * MT};
            pg8::gemm_phase<pg8::EpiStoreBf16, pg8::StaticOrder, true, true>(F.lds, g, S, E); }
        tail_transposes(args, F, 2, (MT / 256) * (INW / 256));
        GRID_BAR();
        prep_phase(args, F, 1, P_Z, P_MIX, P_KB, P_VB);
        GRID_BAR();
        attention_phase(F, 1, (char*)lds, P_MIX, P_KB, P_VB);
        GRID_BAR();
        {   pg8::Gemm g{P_MIX, (const bf16*)(WSL() + WS_WOUT) + (size_t)1 * 1024 * 1024, Mrows, 1024, 1024};
            pg8::EpiResid<false> E{P_XH, P_XH, (P_MOD + (size_t)1 * 9 * MODW) + 2048, A.in[7] + 1 * DMODEL, (P_MOD + (size_t)1 * 9 * MODW) + 4096, P_H, P_RSS + (1 == 0 ? 0 : 2) * MT};
            pg8::StaticOrder S; S.init(NLAT, 1024, F.G, (int)blockIdx.x); pg8::gemm_phase<pg8::EpiResid<false>, pg8::StaticOrder, false, true>(F.lds, g, S, E);
            if (1 == 0) { pg8::SliceOrder S2; S2.init(1024, KSPLIT, F.G, (int)blockIdx.x); pg8::EpiSlab E2{P_SLABS}; pg8::gemm_phase<pg8::EpiSlab, pg8::SliceOrder, true, true>(F.lds, g, S2, E2); } }
        GRID_BAR();
        if (1 == 0) { ctx_combine_phase(F, P_SLABS, ((1 == 0) ? A.in[2] : (const float*)P_CTXRES), P_CTXRES, (P_MOD + (size_t)1 * 9 * MODW) + 2048, A.in[7] + 1 * DMODEL, (P_MOD + (size_t)1 * 9 * MODW) + 4096, P_H, P_RSS + 0 * MT); GRID_BAR(); }
        {   pg8::Gemm g{P_H, (const bf16*)(WSL() + WS_WGU) + (size_t)1 * 2 * FF * 1024, Mrows, 2 * FF, 1024}; pg8::StaticOrder S; S.init(Mrows, 2 * FF, F.G, (int)blockIdx.x);
            pg8::EpiSwiGLU E{P_ACT, FF, P_RSS + (1 == 0 ? 0 : 2) * MT, P_BIASGU + (size_t)1 * 9 * 2 * FF, 2 * FF, F.lds, nullptr};
            pg8::gemm_phase<pg8::EpiSwiGLU, pg8::StaticOrder, true, true>(F.lds, g, S, E); }
        GRID_BAR();
        {   pg8::Gemm g{P_ACT, (const bf16*)(WSL() + WS_WDN) + (size_t)1 * 1024 * FF, Mrows, 1024, FF}; pg8::StaticOrder S; S.init(NLAT, 1024, F.G, (int)blockIdx.x);
            const int nl = (1 + 1 < DEPTH) ? 1 + 1 : 1;
            if (F.G == 256) {
                pg8::EpiResidFinal E{P_XH, P_XRES, (P_MOD + (size_t)1 * 9 * MODW) + 5120, A.in[20], P_RSS + 4 * MT, (unsigned*)(WSL() + WS_CTL) + CW_PANEL, (LAS unsigned*)(F.lds + MISC_OFF) + 20};
                pg8::gemm_phase<pg8::EpiResidFinal, pg8::StaticOrder, true, true>(F.lds, g, S, E);
            } else {
            pg8::EpiResid<false> E{P_XH, P_XH, (P_MOD + (size_t)1 * 9 * MODW) + 5120, A.in[6] + nl * DMODEL, P_MOD + (size_t)nl * 9 * MODW + 1024, P_H, P_RSS + 1 * MT};
            pg8::gemm_phase<pg8::EpiResid<false>, pg8::StaticOrder, false, true>(F.lds, g, S, E); }
            if (1 == 0) { pg8::SliceOrder S2; S2.init(FF, KSPLIT, F.G, (int)blockIdx.x); pg8::EpiSlab E2{P_SLABS}; pg8::gemm_phase<pg8::EpiSlab, pg8::SliceOrder, true, true>(F.lds, g, S2, E2); } }
        if (F.G != 256) GRID_BAR();
        if (1 == 0) { ctx_combine_phase(F, P_SLABS, P_CTXRES, P_CTXRES, (P_MOD + (size_t)1 * 9 * MODW) + 5120, A.in[6] + 1 * DMODEL, P_MOD + (size_t)1 * 9 * MODW + 1024, P_H, P_RSS + 1 * MT); GRID_BAR(); }
    }
    if (F.G != 256) final_norm_phase(F, P_XH, P_XRES, A.in[20]);
}

extern "C" void kernel_launch(void* const* d_in, const int* in_sizes, int n_in, void* d_out, int out_size, void* d_ws, size_t ws_size, hipStream_t stream) {
    static int grid = 0;
    if (grid == 0) {
        if (n_in != 21 || out_size != NLAT * DMODEL || ws_size < 256 * MiB) { fprintf(stderr, "kernel_launch: unexpected shapes (n_in %d out %d ws %zu)\n", n_in, out_size, ws_size); grid = -1; return; }
        int dev = 0, cus = 0, per_cu = 0;
        hipGetDevice(&dev); hipDeviceGetAttribute(&cus, hipDeviceAttributeMultiprocessorCount, dev);
        if (hipFuncSetAttribute((const void*)fwd_megakernel, hipFuncAttributeMaxDynamicSharedMemorySize, LDS_BYTES) != hipSuccess) { fprintf(stderr, "kernel_launch: hipFuncSetAttribute failed\n"); grid = -1; return; }
        if (hipOccupancyMaxActiveBlocksPerMultiprocessor(&per_cu, (const void*)fwd_megakernel, NTHR, LDS_BYTES) != hipSuccess || per_cu < 1) { fprintf(stderr, "kernel_launch: occupancy query says %d blocks per CU\n", per_cu); (void)hipGetLastError(); grid = -1; return; }
        grid = cus * 1;
        fprintf(stderr, "kernel_launch: grid %d (cus %d, per_cu %d)\n", grid, cus, per_cu);
    }
    if (grid < 0) return;
    (void)hipMemsetAsync((char*)d_ws + WS_CTL, 0, CTL_ZERO_BYTES, stream);
    Args a{};
    for (int i = 0; i < 21; ++i) a.in[i] = (const float*)d_in[i];
    a.out = (float*)d_out; a.ws = (unsigned char*)d_ws; a.pad = 0ull;
    void* kargs[] = {&a};
    hipError_t e = hipLaunchCooperativeKernel((const void*)fwd_megakernel, dim3(grid), dim3(NTHR), kargs, LDS_BYTES, stream);
    if (e != hipSuccess) fprintf(stderr, "kernel_launch: cooperative launch failed: %s (grid %d)\n", hipGetErrorString(e), grid);
}
```

```cpp
#include <hip/hip_runtime.h>
#include <hip/hip_bf16.h>
#include <cstdio>
#include <cstdint>
#include <cmath>
namespace pg8 {
#define PG8_LAS __attribute__((address_space(3)))
typedef unsigned short bf16_t;
typedef short bf16x8 __attribute__((ext_vector_type(8)));
typedef float f32x4 __attribute__((ext_vector_type(4)));
typedef unsigned u32x4 __attribute__((ext_vector_type(4)));
constexpr int BM = 256, BK = 64, HALF = 128, HTB = HALF * BK * 2  , STAGE_BYTES = 8 * HTB, NXCD = 8, WGM = 8;

__host__ __device__ __forceinline__ int lds_byte(int r, int c) { const int st = (r >> 4) * 2 + (c >> 5), rr = r & 15, cc = c & 31, ob = rr * 64 + cc * 2; return st * 1024 + (ob ^ (((ob >> 9) & 1) << 5)); }
__host__ __device__ __forceinline__ void stage_rc(int b, int& R, int& C) { const int st = b / 1024, sb = b % 1024, swz = sb ^ (((sb >> 9) & 1) << 5); R = (st >> 1) * 16 + swz / 64; C = (st & 1) * 32 + (swz % 64) / 2; }
__host__ __device__ __forceinline__ int perm32(int rho) { const int n = rho >> 4, i = rho & 15; return 8 * (i >> 2) + 4 * n + (i & 3); }

struct Unit { int pm, pn, k0b, nt, slice; };
struct Gemm { const bf16_t* A; const bf16_t* Bt; int M, N, K; };

struct StaticOrder {
    static constexpr bool SPLIT = false;
    int nM, nN, nwg, G, c;
    __host__ __device__ void init(int M, int N, int G_, int c_) { nM = M / BM; nN = N / BM; nwg = nM * nN; G = G_; c = c_; }
    __host__ __device__ bool next(int i, Unit& u) const { const long L = (long)i * G + c; if (L >= nwg) return false; map((int)L, u); return true; }
    __host__ __device__ void map(int L, Unit& u) const {
        int wgid = L; { const int q = nwg / NXCD, r = nwg % NXCD, xcd = wgid % NXCD, off = wgid / NXCD; wgid = (xcd < r ? xcd * (q + 1) : r * (q + 1) + (xcd - r) * q) + off; }
        const int nig = WGM * nN, gid = wgid / nig, fm = gid * WGM, gsz = (nM - fm) < WGM ? (nM - fm) : WGM;
        u.pm = fm + ((wgid % nig) % gsz); u.pn = (wgid % nig) / gsz;
    }
    __device__ __forceinline__ void a_ready(const Unit&) const {}
    __device__ __forceinline__ void done(const Unit&) const {}
};

__device__ __forceinline__ unsigned cvt_pk_bf16(float lo, float hi) { unsigned r; asm volatile("v_cvt_pk_bf16_f32 %0, %1, %2" : "=v"(r) : "v"(lo), "v"(hi)); return r; }
typedef float f32x2 __attribute__((ext_vector_type(2)));
typedef unsigned u32x2 __attribute__((ext_vector_type(2)));
constexpr int XOFF = 132096;
struct EpiStoreBf16 {
    static constexpr bool PERM = true, AFTER_DRAIN = false, PREFETCH = true;
    bf16_t* O; int ldc; const float* rss; const float* bias; int ldb; PG8_LAS unsigned char* lds; float* rssv;
    __device__ __forceinline__ void prefetch(const Unit& u, int ui, int tid, int wid) const {
        const float* src = (wid < 4) ? rss + (size_t)u.pm * BM + tid : bias + (size_t)(u.pm < 64 ? (u.pm >> 3) : 8) * ldb + (size_t)u.pn * BM + (tid - 256);
        __builtin_amdgcn_global_load_lds((const unsigned*)src, (PG8_LAS unsigned*)(lds + XOFF + (ui & 1) * 2048 + wid * 256), 4, 0, 0);
    }
    static __device__ __forceinline__ float gelu1(float x) { const float y = 0.7978845608028654f * (x + 0.044715f * x * x * x); return x * __builtin_amdgcn_rcpf(1.0f + __builtin_amdgcn_exp2f(y * -2.8853900817779268f)); }
    __device__ __forceinline__ void operator()(const f32x4 (&acc)[2][2][4][2], const Unit& u, int wr, int wc, int fr, int fq, int ui) const {
        const int row0 = u.pm * BM + wr * 64 + fr, col0 = u.pn * BM + wc * 32 + 8 * fq;
        const bool act = (u.pn == 3) | (u.pn == 4);
        const PG8_LAS float* xs = (const PG8_LAS float*)(lds + XOFF + (ui & 1) * 2048);
        f32x4 bv[2][2];
#pragma unroll
        for (int bj = 0; bj < 2; ++bj)
#pragma unroll
            for (int n = 0; n < 2; ++n) bv[bj][n] = *(const PG8_LAS f32x4*)(xs + 256 + wc * 32 + 8 * fq + bj * HALF + 4 * n);
#pragma unroll
        for (int ai = 0; ai < 2; ++ai)
#pragma unroll
            for (int m = 0; m < 4; ++m) { const int rl = wr * 64 + fr + ai * HALF + m * 16; bf16_t* rowp = O + (size_t)(u.pm * BM + rl) * ldc + col0;
                const float rs = 1.0f / sqrtf(xs[rl] * (1.0f / 1024.0f) + 1e-6f);
                float rsq = 0.f;
#pragma unroll
                for (int bj = 0; bj < 2; ++bj) { f32x4 v0 = acc[ai][bj][m][0] * rs + bv[bj][0], v1 = acc[ai][bj][m][1] * rs + bv[bj][1];
                    if (act) {
#pragma unroll
                        for (int e = 0; e < 4; ++e) { v0[e] = gelu1(v0[e]); v1[e] = gelu1(v1[e]); }
                        rsq += ((v0[0] * v0[0] + v0[1] * v0[1]) + (v0[2] * v0[2] + v0[3] * v0[3])) + ((v1[0] * v1[0] + v1[1] * v1[1]) + (v1[2] * v1[2] + v1[3] * v1[3])); }
                    u32x4 w; w.x = cvt_pk_bf16(v0[0], v0[1]); w.y = cvt_pk_bf16(v0[2], v0[3]); w.z = cvt_pk_bf16(v1[0], v1[1]); w.w = cvt_pk_bf16(v1[2], v1[3]);
                    *(u32x4*)(rowp + bj * HALF) = w; }
                if (u.pn == 4) { rsq += __shfl_xor(rsq, 16); rsq += __shfl_xor(rsq, 32); if (fq == 0) atomicAdd(rssv + (u.pm * BM + rl), rsq); } }
    }
};
__device__ __forceinline__ float silu_mul(float g, float u) { const float e = __builtin_amdgcn_exp2f(g * -1.4426950408889634f); return g * __builtin_amdgcn_rcpf(1.0f + e) * u; }
struct EpiSwiGLU {
    static constexpr bool PERM = true, AFTER_DRAIN = false, PREFETCH = true;
    bf16_t* O; int ldc; const float* rss; const float* bias; int ldb; PG8_LAS unsigned char* lds;
    unsigned* ctx_done;
    __device__ __forceinline__ void prefetch(const Unit& u, int ui, int tid, int wid) const {
        const float* src = (wid < 4) ? rss + (size_t)u.pm * BM + tid : bias + (size_t)(u.pm < 64 ? (u.pm >> 3) : 8) * ldb + (size_t)u.pn * BM + (tid - 256);
        __builtin_amdgcn_global_load_lds((const unsigned*)src, (PG8_LAS unsigned*)(lds + XOFF + (ui & 1) * 2048 + wid * 256), 4, 0, 0);
    }
    __device__ __forceinline__ void operator()(const f32x4 (&acc)[2][2][4][2], const Unit& u, int wr, int wc, int fr, int fq, int ui) const {
        const int col0 = u.pn * HALF + wc * 32 + 8 * fq;
        const PG8_LAS float* xs = (const PG8_LAS float*)(lds + XOFF + (ui & 1) * 2048);
        const PG8_LAS float* bp = xs + 256 + wc * 32 + 8 * fq;
        const f32x4 bg0 = *(const PG8_LAS f32x4*)(bp), bg1 = *(const PG8_LAS f32x4*)(bp + 4), bu0 = *(const PG8_LAS f32x4*)(bp + HALF), bu1 = *(const PG8_LAS f32x4*)(bp + HALF + 4);
#pragma unroll
        for (int ai = 0; ai < 2; ++ai)
#pragma unroll
            for (int m = 0; m < 4; ++m) { const int rl = wr * 64 + fr + ai * HALF + m * 16; bf16_t* rowp = O + (size_t)(u.pm * BM + rl) * ldc + col0;
                const float rs = 1.0f / sqrtf(xs[rl] * (1.0f / 1024.0f) + 1e-6f);
                const f32x4 g0 = acc[ai][0][m][0] * rs + bg0, g1 = acc[ai][0][m][1] * rs + bg1, u0 = acc[ai][1][m][0] * rs + bu0, u1 = acc[ai][1][m][1] * rs + bu1;
                u32x4 w; w.x = cvt_pk_bf16(silu_mul(g0[0], u0[0]), silu_mul(g0[1], u0[1])); w.y = cvt_pk_bf16(silu_mul(g0[2], u0[2]), silu_mul(g0[3], u0[3]));
                w.z = cvt_pk_bf16(silu_mul(g1[0], u1[0]), silu_mul(g1[1], u1[1])); w.w = cvt_pk_bf16(silu_mul(g1[2], u1[2]), silu_mul(g1[3], u1[3]));
                *(u32x4*)rowp = w; }
        if (ctx_done != nullptr && u.pm >= 64) {
            asm volatile("s_waitcnt vmcnt(0)" ::: "memory"); __builtin_amdgcn_s_barrier(); asm volatile("" ::: "memory");
            if (threadIdx.x == 0) { __builtin_amdgcn_fence(__ATOMIC_RELEASE, "agent"); asm volatile("s_waitcnt vmcnt(0)" ::: "memory");
                __hip_atomic_fetch_add(ctx_done, 1u, __ATOMIC_RELAXED, __HIP_MEMORY_SCOPE_AGENT); } }
    }
};
struct CtxFirstOrder {
    static constexpr bool SPLIT = false;
    StaticOrder so;
    __host__ __device__ void init(int N, int G_, int c_) { so.init(16384, N, G_, c_); }
    __host__ __device__ int nctx() const { return 8 * so.nN; }
    __host__ __device__ bool next(int i, Unit& u) const {
        const long L = (long)i * so.G + so.c; const int nc = 8 * so.nN;
        if (L < nc) { u.pm = 64 + (int)(L & 7); u.pn = (int)(L >> 3); return true; }
        if (L - nc >= so.nwg) return false;
        so.map((int)(L - nc), u); return true;
    }
    __device__ __forceinline__ void a_ready(const Unit&) const {}
    __device__ __forceinline__ void done(const Unit&) const {}
};
struct SliceOrder {
    static constexpr bool SPLIT = true;
    int G, c, S, ntf;
    __host__ __device__ void init(int K, int S_, int G_, int c_) { G = G_; c = c_; S = S_; ntf = K / BK; }
    __host__ __device__ bool next(int i, Unit& u) const {
        const long L = (long)i * G + c; if (L >= 32 * S) return false;
        const int s = (int)L, tile = s / S, sl = s % S, P = ntf / 2, base = P / S, rem = P % S;
        u.pm = 64 + (tile & 7); u.pn = tile >> 3; u.nt = 2 * (base + (sl < rem ? 1 : 0)); u.k0b = (sl * base + (sl < rem ? sl : rem)) * 256; u.slice = s; return true;
    }
    __device__ __forceinline__ void a_ready(const Unit&) const {}
    __device__ __forceinline__ void done(const Unit&) const {}
};
struct EpiSlab {
    static constexpr bool PERM = true, AFTER_DRAIN = false, PREFETCH = false;
    float* slabs;
    __device__ __forceinline__ void operator()(const f32x4 (&acc)[2][2][4][2], const Unit& u, int wr, int wc, int fr, int fq) const {
        float* sp_ = slabs + (size_t)u.slice * 65536 + wc * 32 + 8 * fq + (size_t)(wr * 64 + fr) * 256;
#pragma unroll
        for (int ai = 0; ai < 2; ++ai)
#pragma unroll
            for (int m = 0; m < 4; ++m) { float* q = sp_ + (ai * HALF + m * 16) * 256;
                *(f32x4*)q = acc[ai][0][m][0]; *(f32x4*)(q + 4) = acc[ai][0][m][1]; *(f32x4*)(q + HALF) = acc[ai][1][m][0]; *(f32x4*)(q + HALF + 4) = acc[ai][1][m][1]; }
    }
};
typedef _Float16 f16x8 __attribute__((ext_vector_type(8)));
typedef float f32x8 __attribute__((ext_vector_type(8)));
__device__ __forceinline__ u32x4 pack_h8(const f32x4 a, const f32x4 b) { const f32x8 v = {a[0], a[1], a[2], a[3], b[0], b[1], b[2], b[3]}; return __builtin_bit_cast(u32x4, __builtin_convertvector(v, f16x8)); }
__device__ __forceinline__ void unpack_h8(const u32x4 w, f32x4& a, f32x4& b) { const f32x8 v = __builtin_convertvector(__builtin_bit_cast(f16x8, w), f32x8); a = (f32x4){v[0], v[1], v[2], v[3]}; b = (f32x4){v[4], v[5], v[6], v[7]}; }
template <bool BASEF32> struct EpiResid {
    static constexpr bool PERM = true, AFTER_DRAIN = false, PREFETCH = false;
    static constexpr int LDC = 1024, MODLD = 6144;
    const void* base; unsigned short* xh; const float* gate;
    const float* gn; const float* scn; bf16_t* H; float* rss;
    __device__ __forceinline__ void operator()(const f32x4 (&acc)[2][2][4][2], const Unit& u, int wr, int wc, int fr_in, int fq) const {
        int fr = fr_in; asm volatile("" : "+v"(fr));
        const int b = u.pm >> 3; const size_t t0 = (size_t)u.pm * BM * LDC;
        const float* bpf = (const float*)base + t0; const unsigned short* bph = (const unsigned short*)base + t0; unsigned short* op = xh + t0;
        const float* gp = gate + (size_t)b * MODLD; const float* sp = scn + (size_t)b * MODLD;
        const int col0 = u.pn * BM + wc * 32 + 8 * fq;
        float rsum[2][4];
#pragma unroll
        for (int ai = 0; ai < 2; ++ai)
#pragma unroll
            for (int m = 0; m < 4; ++m) rsum[ai][m] = 0.f;
#pragma unroll
        for (int bj = 0; bj < 2; ++bj) { const int cc = col0 + bj * HALF;
            const f32x4 gv0 = *(const f32x4*)(gp + cc), gv1 = *(const f32x4*)(gp + cc + 4);
            const f32x4 Gn0 = *(const f32x4*)(gn + cc) * (*(const f32x4*)(sp + cc) + 1.0f), Gn1 = *(const f32x4*)(gn + cc + 4) * (*(const f32x4*)(sp + cc + 4) + 1.0f);
#pragma unroll
            for (int am = 0; am < 4; ++am) { const int ai = am >> 1, mb = (am & 1) * 2; f32x4 b0[4], b1[4];
#pragma unroll
                for (int m = mb; m < mb + 2; ++m) { const size_t off = (size_t)(ai * HALF + wr * 64 + m * 16 + fr) * LDC + cc;
                    if constexpr (BASEF32) { b0[m] = __builtin_nontemporal_load((const f32x4*)(bpf + off)); b1[m] = __builtin_nontemporal_load((const f32x4*)(bpf + off + 4)); }
                    else { const u32x4 w = __builtin_nontemporal_load((const u32x4*)(bph + off)); unpack_h8(w, b0[m], b1[m]); } }
#pragma unroll
                for (int m = mb; m < mb + 2; ++m) { const int rl = ai * HALF + wr * 64 + m * 16 + fr; const size_t off = (size_t)rl * LDC + cc;
                    const f32x4 x0 = b0[m] + gv0 * acc[ai][bj][m][0], x1 = b1[m] + gv1 * acc[ai][bj][m][1]; *(u32x4*)(op + off) = pack_h8(x0, x1);
                    rsum[ai][m] += ((x0[0] * x0[0] + x0[1] * x0[1]) + (x0[2] * x0[2] + x0[3] * x0[3])) + ((x1[0] * x1[0] + x1[1] * x1[1]) + (x1[2] * x1[2] + x1[3] * x1[3]));
                    const f32x4 a0 = x0 * Gn0, a1 = x1 * Gn1;
                    u32x4 w; w.x = cvt_pk_bf16(a0[0], a0[1]); w.y = cvt_pk_bf16(a0[2], a0[3]); w.z = cvt_pk_bf16(a1[0], a1[1]); w.w = cvt_pk_bf16(a1[2], a1[3]);
                    *(u32x4*)(H + (size_t)(u.pm * BM + rl) * LDC + cc) = w; } } }
        {
#pragma unroll
            for (int ai = 0; ai < 2; ++ai)
#pragma unroll
                for (int m = 0; m < 4; ++m) { float sv = rsum[ai][m]; sv += __shfl_xor(sv, 16); sv += __shfl_xor(sv, 32);
                    if (fq == 0) atomicAdd(rss + (u.pm * BM + ai * HALF + wr * 64 + m * 16 + fr), sv); } }
    }
};

struct EpiResidFinal {
    static constexpr bool PERM = true, AFTER_DRAIN = false, PREFETCH = false;
    static constexpr int LDC = 1024, MODLD = 6144;
    const unsigned short* base; float* out; const float* gate; const float* fnorm; float* rss; unsigned* cnt; PG8_LAS unsigned* flag;
    __device__ __forceinline__ void operator()(f32x4 (&acc)[2][2][4][2], const Unit& u, int wr, int wc, int fr_in, int fq) const {
        int fr = fr_in; asm volatile("" : "+v"(fr));
        const int b = u.pm >> 3;
        const unsigned short* bp = base + (size_t)u.pm * BM * LDC; float* op = out + (size_t)u.pm * BM * LDC;
        const float* gp = gate + (size_t)b * MODLD;
        const int col0 = u.pn * BM + wc * 32 + 8 * fq;
        float rsum[2][4];
#pragma unroll
        for (int ai = 0; ai < 2; ++ai)
#pragma unroll
            for (int m = 0; m < 4; ++m) rsum[ai][m] = 0.f;
#pragma unroll
        for (int bj = 0; bj < 2; ++bj) { const int cc = col0 + bj * HALF;
            const f32x4 gv0 = *(const f32x4*)(gp + cc), gv1 = *(const f32x4*)(gp + cc + 4);
#pragma unroll
            for (int am = 0; am < 4; ++am) { const int ai = am >> 1, mb = (am & 1) * 2; f32x4 b0[4], b1[4];
#pragma unroll
                for (int m = mb; m < mb + 2; ++m) { const u32x4 w = __builtin_nontemporal_load((const u32x4*)(bp + (size_t)(ai * HALF + wr * 64 + m * 16 + fr) * LDC + cc)); unpack_h8(w, b0[m], b1[m]); }
#pragma unroll
                for (int m = mb; m < mb + 2; ++m) { const f32x4 x0 = b0[m] + gv0 * acc[ai][bj][m][0], x1 = b1[m] + gv1 * acc[ai][bj][m][1]; acc[ai][bj][m][0] = x0; acc[ai][bj][m][1] = x1;
                    rsum[ai][m] += ((x0[0] * x0[0] + x0[1] * x0[1]) + (x0[2] * x0[2] + x0[3] * x0[3])) + ((x1[0] * x1[0] + x1[1] * x1[1]) + (x1[2] * x1[2] + x1[3] * x1[3])); }
                asm volatile("" : "+v"(fr) : "v"(rsum[ai][mb + 1]) : "memory"); } }
#pragma unroll
        for (int ai = 0; ai < 2; ++ai)
#pragma unroll
            for (int m = 0; m < 4; ++m) { float sv = rsum[ai][m]; sv += __shfl_xor(sv, 16); sv += __shfl_xor(sv, 32);
                if (fq == 0) atomicAdd(rss + (u.pm * BM + ai * HALF + wr * 64 + m * 16 + fr), sv); }
        asm volatile("s_waitcnt vmcnt(0)" ::: "memory");
        __builtin_amdgcn_s_barrier(); asm volatile("" ::: "memory");
        if (threadIdx.x == 0) {
            __builtin_amdgcn_fence(__ATOMIC_RELEASE, "agent"); asm volatile("s_waitcnt vmcnt(0)" ::: "memory");
            __hip_atomic_fetch_add(cnt + 64 * u.pm, 1u, __ATOMIC_RELAXED, __HIP_MEMORY_SCOPE_AGENT);
            unsigned sp = 0;
            while (__hip_atomic_load(cnt + 64 * u.pm, __ATOMIC_RELAXED, __HIP_MEMORY_SCOPE_AGENT) < 4u) { __builtin_amdgcn_s_sleep(2); if (++sp > (1u << 20)) break; }
            __builtin_amdgcn_fence(__ATOMIC_ACQUIRE, "agent"); asm volatile("s_waitcnt vmcnt(0)" ::: "memory");
            flag[0] = 1u;
        }
        asm volatile("s_waitcnt vmcnt(0) lgkmcnt(0)" ::: "memory");
        __builtin_amdgcn_s_barrier(); asm volatile("" ::: "memory");
        asm volatile("" : "+v"(fr));
        float rs[2][4];
#pragma unroll
        for (int ai = 0; ai < 2; ++ai)
#pragma unroll
            for (int m = 0; m < 4; ++m) { float* q = rss + (u.pm * BM + ai * HALF + wr * 64 + m * 16 + fr); asm volatile("" : "+v"(q)); rs[ai][m] = 1.0f / sqrtf(__hip_atomic_load(q, __ATOMIC_RELAXED, __HIP_MEMORY_SCOPE_AGENT) * (1.0f / 1024.0f) + 1e-6f); }
#pragma unroll
        for (int bj = 0; bj < 2; ++bj) { const int cc = col0 + bj * HALF; const f32x4 f0 = *(const f32x4*)(fnorm + cc), f1 = *(const f32x4*)(fnorm + cc + 4);
#pragma unroll
            for (int ai = 0; ai < 2; ++ai)
#pragma unroll
                for (int m = 0; m < 4; ++m) { float* q = op + (size_t)(ai * HALF + wr * 64 + m * 16 + fr) * LDC + cc; asm volatile("" : "+v"(q));
                    *(f32x4*)q = acc[ai][bj][m][0] * rs[ai][m] * f0; *(f32x4*)(q + 4) = acc[ai][bj][m][1] * rs[ai][m] * f1; } }
    }
};
template <class Epi, class Sched, bool ALIGN_EPI = false, bool SP2 = false>
__device__ __forceinline__ void gemm_phase(PG8_LAS unsigned char* lds, const Gemm g, const Sched& S, const Epi& E) {
    int tid_ = threadIdx.x; asm volatile("" : "+v"(tid_));
    const int tid = tid_, wid = __builtin_amdgcn_readfirstlane(tid >> 6), lane = tid & 63, wr = wid >> 2, wc = wid & 3, fr = lane & 15, fq = lane >> 4;
    const int K = g.K, nt = K / BK;
    unsigned voffA[2], voffB[2];
#pragma unroll
    for (int i = 0; i < 2; ++i) { int R, C; stage_rc(tid * 16 + i * 8192, R, C); const int Rb = Epi::PERM ? ((R & ~31) + perm32(R & 31)) : R;
        voffA[i] = (unsigned)(R * K + C) * 2u; voffB[i] = (unsigned)(Rb * K + C) * 2u; }
    const size_t kstep = (size_t)(BK * 2);
    const size_t hstep = (size_t)HALF * K * 2;
    const size_t tstep = 2 * hstep;
    const unsigned ldsw = (unsigned)wid * 1024u;
    const int aoff = lds_byte(wr * 64 + fr, fq * 8), boff = lds_byte(wc * 32 + fr, fq * 8);
#define PG8_SA(b, h) (((b) * 2 + (h)) * HTB)
#define PG8_SB(b, h) ((4 + (b) * 2 + (h)) * HTB)
#define PG8_STAGE(bufoff, gbase, voff) do { _Pragma("unroll") for (int _i = 0; _i < 2; ++_i) \
        __builtin_amdgcn_global_load_lds((const unsigned*)((const char*)(gbase) + (voff)[_i]), (PG8_LAS unsigned*)(lds + (bufoff) + ldsw + _i * 8192), 16, 0, 0); } while (0)
#define PG8_LDA(dst, b, h) do { _Pragma("unroll") for (int m = 0; m < 4; ++m) _Pragma("unroll") for (int k = 0; k < 2; ++k) dst[m][k] = *(const PG8_LAS bf16x8*)(lds + PG8_SA(b, h) + aoff + m * 2048 + k * 1024); } while (0)
#define PG8_LDB(dst, b, h) do { _Pragma("unroll") for (int n = 0; n < 2; ++n) _Pragma("unroll") for (int k = 0; k < 2; ++k) dst[n][k] = *(const PG8_LAS bf16x8*)(lds + PG8_SB(b, h) + boff + n * 2048 + k * 1024); } while (0)
#define PG8_MMA(ai, bj, At, Bt) do { __builtin_amdgcn_s_setprio(1); _Pragma("unroll") for (int m = 0; m < 4; ++m) _Pragma("unroll") for (int n = 0; n < 2; ++n) _Pragma("unroll") for (int k = 0; k < 2; ++k) \
        acc[ai][bj][m][n] = __builtin_amdgcn_mfma_f32_16x16x32_bf16(Bt[n][k], At[m][k], acc[ai][bj][m][n], 0, 0, 0); __builtin_amdgcn_s_setprio(0); } while (0)
#define PG8_WAIT_V(n) asm volatile("s_waitcnt vmcnt(" #n ")" ::: "memory")
#define PG8_WAIT_L(n) asm volatile("s_waitcnt lgkmcnt(" #n ")" ::: "memory")
#define PG8_BAR __builtin_amdgcn_s_barrier()
#define PG8_SCHED __builtin_amdgcn_sched_barrier(0)
    Unit cur, nxt; int ui = 0;
    if (!S.next(0, cur)) return;
    if constexpr (!Sched::SPLIT) { cur.k0b = 0; cur.nt = nt; cur.slice = -1; }
    f32x4 acc[2][2][4][2];
#pragma unroll
    for (int a = 0; a < 2; ++a)
#pragma unroll
        for (int b = 0; b < 2; ++b)
#pragma unroll
            for (int m = 0; m < 4; ++m)
#pragma unroll
                for (int n = 0; n < 2; ++n) acc[a][b][m][n] = (f32x4){0.f, 0.f, 0.f, 0.f};
    bf16x8 At[4][2], B0[2][2], B1[2][2];
    const char* cA = (const char*)g.A + (size_t)cur.pm * tstep + cur.k0b; const char* cB = (const char*)g.Bt + (size_t)cur.pn * tstep + cur.k0b;
    S.a_ready(cur);
    if constexpr (SP2) {
        PG8_STAGE(PG8_SB(0, 0), cB, voffB); PG8_STAGE(PG8_SB(0, 1), cB + hstep, voffB); PG8_STAGE(PG8_SA(0, 0), cA, voffA); PG8_STAGE(PG8_SA(0, 1), cA + hstep, voffA);
        if (wr == 1) PG8_BAR;
        PG8_WAIT_V(2); PG8_BAR;
        PG8_STAGE(PG8_SB(1, 0), cB + kstep, voffB); PG8_STAGE(PG8_SA(1, 0), cA + kstep, voffA); PG8_STAGE(PG8_SB(1, 1), cB + hstep + kstep, voffB);
        PG8_WAIT_V(6); PG8_BAR;
    } else {
        PG8_STAGE(PG8_SB(0, 0), cB, voffB); PG8_STAGE(PG8_SA(0, 0), cA, voffA); PG8_STAGE(PG8_SB(0, 1), cB + hstep, voffB); PG8_STAGE(PG8_SA(0, 1), cA + hstep, voffA);
        if (wr == 1) PG8_BAR;
        PG8_WAIT_V(4); PG8_BAR;
        PG8_STAGE(PG8_SB(1, 0), cB + kstep, voffB); PG8_STAGE(PG8_SA(1, 0), cA + kstep, voffA); PG8_STAGE(PG8_SB(1, 1), cB + hstep + kstep, voffB);
        PG8_WAIT_V(6); PG8_BAR;
    }
    for (;;) {
        if constexpr (Epi::PREFETCH) E.prefetch(cur, ui, tid, wid);
        const bool has_next = S.next(ui + 1, nxt);
        if constexpr (!Sched::SPLIT) { nxt.k0b = 0; nxt.nt = nt; nxt.slice = -1; }
        const int unt = cur.nt;
        const char* nA = has_next ? (const char*)g.A + (size_t)nxt.pm * tstep + nxt.k0b : cA; const char* nB = has_next ? (const char*)g.Bt + (size_t)nxt.pn * tstep + nxt.k0b : cB;
        for (int t = 0; t < unt; t += 2) {
            const bool last = (t == unt - 2);
            const char* a1 = cA + (size_t)(t + 1) * kstep;
            const char* a2 = last ? nA : cA + (size_t)(t + 2) * kstep; const char* b2 = last ? nB : cB + (size_t)(t + 2) * kstep;
            const char* a3 = a2 + kstep; const char* b3 = b2 + kstep;
            if (last && has_next) S.a_ready(nxt);
            if constexpr (SP2) {
            PG8_LDB(B0, 0, 0); PG8_LDB(B1, 0, 1); PG8_SCHED; PG8_LDA(At, 0, 0); PG8_STAGE(PG8_SA(1, 1), a1 + hstep, voffA);
            PG8_WAIT_V(8); PG8_WAIT_L(0); PG8_BAR; PG8_MMA(0, 0, At, B0); PG8_MMA(0, 1, At, B1); PG8_BAR; PG8_SCHED;
            PG8_LDA(At, 0, 1); PG8_STAGE(PG8_SB(0, 0), b2, voffB); PG8_STAGE(PG8_SB(0, 1), b2 + hstep, voffB); PG8_STAGE(PG8_SA(0, 0), a2, voffA);
            PG8_WAIT_V(8); PG8_WAIT_L(0); PG8_BAR; PG8_MMA(1, 0, At, B0); PG8_MMA(1, 1, At, B1); PG8_BAR; PG8_SCHED;
            PG8_LDB(B0, 1, 0); PG8_LDB(B1, 1, 1); PG8_SCHED; PG8_LDA(At, 1, 0); PG8_STAGE(PG8_SA(0, 1), a2 + hstep, voffA);
            PG8_WAIT_V(8); PG8_WAIT_L(0); PG8_BAR; PG8_MMA(0, 0, At, B0); PG8_MMA(0, 1, At, B1); PG8_BAR; PG8_SCHED;
            PG8_LDA(At, 1, 1); PG8_STAGE(PG8_SB(1, 0), b3, voffB); PG8_STAGE(PG8_SB(1, 1), b3 + hstep, voffB); PG8_STAGE(PG8_SA(1, 0), a3, voffA);
            PG8_WAIT_V(8); PG8_WAIT_L(0); PG8_BAR; PG8_MMA(1, 0, At, B0); PG8_MMA(1, 1, At, B1); PG8_BAR; PG8_SCHED;
            } else {
            PG8_LDB(B0, 0, 0); PG8_SCHED; PG8_LDA(At, 0, 0); PG8_STAGE(PG8_SA(1, 1), a1 + hstep, voffA);
            PG8_WAIT_L(8); PG8_BAR; PG8_WAIT_L(0); PG8_MMA(0, 0, At, B0); PG8_BAR; PG8_SCHED;
            PG8_LDB(B1, 0, 1); PG8_STAGE(PG8_SB(0, 0), b2, voffB);
            PG8_BAR; PG8_WAIT_L(0); PG8_MMA(0, 1, At, B1); PG8_BAR;
            PG8_LDA(At, 0, 1); PG8_STAGE(PG8_SA(0, 0), a2, voffA);
            PG8_BAR; PG8_WAIT_L(0); PG8_MMA(1, 0, At, B0); PG8_BAR; PG8_SCHED;
            PG8_STAGE(PG8_SB(0, 1), b2 + hstep, voffB);
            PG8_WAIT_V(6); PG8_BAR; PG8_MMA(1, 1, At, B1); PG8_BAR;
            PG8_LDB(B0, 1, 0); PG8_SCHED; PG8_LDA(At, 1, 0); PG8_STAGE(PG8_SA(0, 1), a2 + hstep, voffA);
            PG8_WAIT_L(8); PG8_BAR; PG8_WAIT_L(0); PG8_MMA(0, 0, At, B0); PG8_BAR; PG8_SCHED;
            PG8_LDB(B1, 1, 1); PG8_STAGE(PG8_SB(1, 0), b3, voffB);
            PG8_BAR; PG8_WAIT_L(0); PG8_MMA(0, 1, At, B1); PG8_BAR;
            PG8_LDA(At, 1, 1); PG8_STAGE(PG8_SA(1, 0), a3, voffA);
            PG8_BAR; PG8_WAIT_L(0); PG8_MMA(1, 0, At, B0); PG8_BAR; PG8_SCHED;
            PG8_STAGE(PG8_SB(1, 1), b3 + hstep, voffB);
            PG8_WAIT_V(6); PG8_BAR; PG8_MMA(1, 1, At, B1); PG8_BAR;
            }
        }
        if constexpr (ALIGN_EPI) { if (wr == 0) PG8_BAR; }
        if constexpr (!Epi::AFTER_DRAIN) { if constexpr (Epi::PREFETCH) E(acc, cur, wr, wc, fr, fq, ui); else E(acc, cur, wr, wc, fr, fq); S.done(cur); }
        if (!has_next) break;
#pragma unroll
        for (int a = 0; a < 2; ++a)
#pragma unroll
            for (int b = 0; b < 2; ++b)
#pragma unroll
                for (int m = 0; m < 4; ++m)
#pragma unroll
                    for (int n = 0; n < 2; ++n) acc[a][b][m][n] = (f32x4){0.f, 0.f, 0.f, 0.f};
        cur = nxt; cA = nA; cB = nB; ++ui;
        if constexpr (ALIGN_EPI) { if (wr == 1) PG8_BAR; }
    }
    PG8_WAIT_V(0);
    if constexpr (!ALIGN_EPI) { if (wr == 0) PG8_BAR; }
    PG8_BAR;
    if constexpr (Epi::AFTER_DRAIN) { E.fused(acc, cur, wr, wc, fr, fq, lds, wid, lane); S.done(cur); }
#undef PG8_SA
#undef PG8_SB
#undef PG8_STAGE
#undef PG8_LDA
#undef PG8_LDB
#undef PG8_MMA
#undef PG8_WAIT_V
#undef PG8_WAIT_L
#undef PG8_BAR
#undef PG8_SCHED
}
}
#include <hip/hip_bf16.h>
#include <cmath>
namespace attn_body {
using bf16=__hip_bfloat16;
using bf16x8=__attribute__((ext_vector_type(8)))short;
using s16x4=__attribute__((ext_vector_type(4)))short;
using f32x16=__attribute__((ext_vector_type(16)))float;
using u32x4=__attribute__((ext_vector_type(4)))unsigned;
constexpr int D=64,QP=1024,KP=128;
constexpr int NW=8,QBLK=32,QB=QBLK*NW,KVBLK=64;
__device__ __forceinline__ int crow(int r,int hi){return (r&3)+8*(r>>2)+4*hi;}
#define SBAR() __builtin_amdgcn_sched_barrier(0)
__device__ __forceinline__ void cmask(f32x16&p0,f32x16&p1,int jb,int qrel,int hi){
  const float NEG=-INFINITY; int kb=64*jb+4*hi;
  #pragma unroll
  for(int r=0;r<16;++r){int kv=kb+(r&3)+8*(r>>2); if(kv>qrel)p0[r]=NEG; if(kv+32>qrel)p1[r]=NEG;}
}

constexpr int NSLOT=3, SLOTB=8192;
constexpr int LDS_K=0, LDS_V=NSLOT*SLOTB, LDS_WS=2*NSLOT*SLOTB, LDS_OST=LDS_WS+NW*64*4, LDS_BYTES=LDS_OST+NW*4096;
constexpr float C2=0.125f*1.4426950408889634f;
__device__ __forceinline__ void glds16(const void*gsrc,unsigned lds_dst){unsigned keep;
  asm volatile("s_mov_b32 %0, m0\n\ts_mov_b32 m0, %2\n\ts_nop 0\n\tglobal_load_lds_dwordx4 %1, off\n\ts_mov_b32 m0, %0":"=&s"(keep):"v"(gsrc),"s"(lds_dst):"memory");}
__device__ __forceinline__ float max3f(float a,float b,float c){float r;asm("v_max3_f32 %0, %1, %2, %3":"=v"(r):"v"(a),"v"(b),"v"(c));return r;}
__device__ __forceinline__ float max2f(float a,float b){float r;asm("v_max_f32_e32 %0, %1, %2":"=v"(r):"v"(a),"v"(b));return r;}
__device__ __forceinline__ float fadd_s(float a,float b){float r;asm("v_add_f32_e32 %0, %1, %2":"=v"(r):"v"(a),"v"(b));return r;}
__device__ __forceinline__ float fsub_s(float a,float b){float r;asm("v_sub_f32_e32 %0, %1, %2":"=v"(r):"v"(a),"v"(b));return r;}
typedef float f32x2_t __attribute__((ext_vector_type(2))); typedef __bf16 bf16x2_t __attribute__((ext_vector_type(2)));
__device__ __forceinline__ unsigned cvtpk_s(float lo,float hi){f32x2_t v={lo,hi};bf16x2_t b=__builtin_convertvector(v,bf16x2_t);return __builtin_bit_cast(unsigned,b);}
#define WAIT_BAR(N) asm volatile("s_waitcnt vmcnt(" #N ") lgkmcnt(0)\n\ts_barrier":::"memory")

__device__ __forceinline__ void qkt(f32x16&p0,f32x16&p1,const char*Kslot,const bf16x8*qr,const f32x16&negm,int r32,int hi){
  const char*kb=Kslot+hi*1024+r32*16;
  #pragma unroll
  for(int d0=0;d0<4;++d0){
    const bf16x8 b0=*reinterpret_cast<const bf16x8*>(kb+d0*2048);
    const bf16x8 b1=*reinterpret_cast<const bf16x8*>(kb+d0*2048+512);
    if(d0==0){p0=__builtin_amdgcn_mfma_f32_32x32x16_bf16(b0,qr[0],negm,0,0,0);p1=__builtin_amdgcn_mfma_f32_32x32x16_bf16(b1,qr[0],negm,0,0,0);}
    else{p0=__builtin_amdgcn_mfma_f32_32x32x16_bf16(b0,qr[d0],p0,0,0,0);p1=__builtin_amdgcn_mfma_f32_32x32x16_bf16(b1,qr[d0],p1,0,0,0);}}
}
typedef __attribute__((address_space(3))) const char* lds_cptr;
typedef short v4i16_t __attribute__((ext_vector_type(4)));
__device__ __forceinline__ void kload8(bf16x8*kf,lds_cptr kp){
  kf[0]=*(const __attribute__((address_space(3))) bf16x8*)(kp);      kf[1]=*(const __attribute__((address_space(3))) bf16x8*)(kp+512);
  kf[2]=*(const __attribute__((address_space(3))) bf16x8*)(kp+2048); kf[3]=*(const __attribute__((address_space(3))) bf16x8*)(kp+2560);
  kf[4]=*(const __attribute__((address_space(3))) bf16x8*)(kp+4096); kf[5]=*(const __attribute__((address_space(3))) bf16x8*)(kp+4608);
  kf[6]=*(const __attribute__((address_space(3))) bf16x8*)(kp+6144); kf[7]=*(const __attribute__((address_space(3))) bf16x8*)(kp+6656);
}
__device__ __forceinline__ void kload2(bf16x8*kf,lds_cptr kp,int j){ kf[2*j]=*(const __attribute__((address_space(3))) bf16x8*)(kp+j*2048); kf[2*j+1]=*(const __attribute__((address_space(3))) bf16x8*)(kp+j*2048+512); }
__device__ __forceinline__ s16x4 vtr(lds_cptr p){ return __builtin_bit_cast(s16x4,__builtin_amdgcn_ds_read_tr16_b64_v4i16((__attribute__((address_space(3))) v4i16_t*)p)); }
__device__ __forceinline__ float rowmax(const f32x16&p0,const f32x16&p1){
  float a=max3f(p0[0],p0[1],p1[0]),b=max3f(p0[2],p0[3],p1[1]);a=max3f(a,p1[2],p1[3]);
  #pragma unroll
  for(int r=4;r<16;r+=4){a=max3f(a,p0[r],p0[r+1]);b=max3f(b,p0[r+2],p0[r+3]);a=max3f(a,p1[r],p1[r+1]);b=max3f(b,p1[r+2],p1[r+3]);}
  const float m=max2f(a,b);
  auto rr=__builtin_amdgcn_permlane32_swap(__float_as_uint(m),__float_as_uint(m),false,false);
  return max2f(__uint_as_float(rr[0]),__uint_as_float(rr[1]));
}
__device__ __forceinline__ void pv(f32x16*o,int vb,bf16x8 pa0,bf16x8 pa1,bf16x8 pa2,bf16x8 pa3){
  #pragma unroll
  for(int d0=0;d0<2;++d0){s16x4 lo[4],hi[4];
    #pragma unroll
    for(int ks=0;ks<4;++ks){
      asm volatile("ds_read_b64_tr_b16 %0,%1 offset:%c2":"=&v"(lo[ks]):"v"(vb),"i"(d0*4096+ks*1024):"memory");
      asm volatile("ds_read_b64_tr_b16 %0,%1 offset:%c2":"=&v"(hi[ks]):"v"(vb),"i"(d0*4096+ks*1024+512):"memory");}
    asm volatile("s_waitcnt lgkmcnt(0)":::"memory");SBAR();
    #define PK(k) (bf16x8){lo[k][0],lo[k][1],lo[k][2],lo[k][3],hi[k][0],hi[k][1],hi[k][2],hi[k][3]}
    o[d0]=__builtin_amdgcn_mfma_f32_32x32x16_bf16(pa0,PK(0),o[d0],0,0,0);
    o[d0]=__builtin_amdgcn_mfma_f32_32x32x16_bf16(pa1,PK(1),o[d0],0,0,0);
    o[d0]=__builtin_amdgcn_mfma_f32_32x32x16_bf16(pa2,PK(2),o[d0],0,0,0);
    o[d0]=__builtin_amdgcn_mfma_f32_32x32x16_bf16(pa3,PK(3),o[d0],0,0,0);
    #undef PK
  }
}

#ifndef ATTN_STORE16
#define ATTN_STORE16(p,v) (*(u32x4*)(p)=(v))
#endif
template<int THRL> __device__ __forceinline__ void attn_unit(const bf16*Qw0,const bf16*__restrict__ Kh,const bf16*__restrict__ Vh,bf16*Ow0,const int NT,char*shm){
  int tid_=threadIdx.x; asm volatile("":"+v"(tid_)); const int tid=tid_,lane=tid&63,r32=lane&31,hi=lane>>5; const int wid=__builtin_amdgcn_readfirstlane(tid>>6);
  const bf16*Qw=Qw0+(long)(wid*QBLK)*QP;
  const unsigned lds0=(unsigned)(uintptr_t)shm;
  float*wsf=(float*)(shm+LDS_WS)+wid*64;
  const bf16*ksrc=Kh+(long)lane*KP+wid*8;
  const bf16*vsrc=Vh+(long)(16*(wid&3)+(lane>>2))*KP+(wid>>2)*32+(lane&3)*8;
  const unsigned kdst=lds0+LDS_K+wid*1024, vdst=lds0+LDS_V+wid*1024;
  #define DMA_K(t,slot) glds16(ksrc+(long)(t)*KVBLK*KP,(unsigned)__builtin_amdgcn_readfirstlane(kdst+(slot)))
  #define DMA_V(t,slot) glds16(vsrc+(long)(t)*KVBLK*KP,(unsigned)__builtin_amdgcn_readfirstlane(vdst+(slot)))
  const int vb0=(int)(lds0+LDS_V)+((lane>>4)&1)*32+(lane&3)*8+(4*hi+((lane&15)>>2))*64;
  const char*Kbase=shm+LDS_K; bf16x8 kf[8];
  const lds_cptr shm3=(lds_cptr)shm; const lds_cptr kp0=shm3+LDS_K+hi*1024+r32*16; const lds_cptr vp0=shm3+LDS_V+((lane>>4)&1)*32+(lane&3)*8+(4*hi+((lane&15)>>2))*64;
  DMA_K(0,0);DMA_V(0,0);DMA_K(1,SLOTB);
  bf16x8 qr[4];
  #pragma unroll
  for(int d0=0;d0<4;++d0)qr[d0]=*reinterpret_cast<const bf16x8*>(&Qw[(long)r32*QP+d0*16+hi*8]);
  float mhat=0.f,l_reg=0.f;f32x16 o[2];o[0]=f32x16{};o[1]=f32x16{};f32x16 negm=f32x16{};asm volatile("":"+v"(negm));
  #define CMASK(P0,P1,t) do{}while(0)
  bool resc=false;
  #define START(P0,P1) do{ const float rm=rowmax(P0,P1); resc=false; \
    { const float dl=rm; mhat=fadd_s(mhat,dl); \
      _Pragma("unroll") for(int r=0;r<16;++r){P0[r]=fsub_s(P0[r],dl);P1[r]=fsub_s(P1[r],dl);} \
      _Pragma("unroll") for(int r=0;r<16;++r)negm[r]=-mhat; asm volatile("":"+v"(negm)); } \
    _Pragma("unroll") for(int r=0;r<16;++r)P0[r]=__builtin_amdgcn_exp2f(P0[r]); }while(0)
  #define RESC() do{ if(resc){ asm volatile("s_waitcnt lgkmcnt(0)":::"memory"); \
      _Pragma("unroll") for(int d_=0;d_<2;++d_) _Pragma("unroll") for(int r=0;r<16;++r)o[d_][r]*=wsf[crow(r,hi)]; } }while(0)
  f32x16 pA0,pA1,pB0,pB1;
  int sl_prev=0,sl_cur=0,sl_next=SLOTB;
  #define ROT() do{sl_prev=sl_cur;sl_cur=sl_next;sl_next=(sl_next==(NSLOT-1)*SLOTB)?0:sl_next+SLOTB;}while(0)
  DMA_K(2,2*SLOTB);
  WAIT_BAR(3);
  qkt(pA0,pA1,Kbase,qr,negm,r32,hi);asm volatile("s_nop 15\n\ts_nop 7":"+v"(pA0),"+v"(pA1));CMASK(pA0,pA1,0);
  START(pA0,pA1);
  _Pragma("unroll") for(int r=0;r<16;++r)pA1[r]=__builtin_amdgcn_exp2f(pA1[r]);
  WAIT_BAR(0);
  DMA_K(3,0);DMA_V(1,SLOTB);
  ROT();
  kload8(kf,kp0+sl_cur);
  WAIT_BAR(2);
  s16x4 vlo[8],vhi[8]; u32x4 pw0,pw1,pw2,pw3;
  #define PKW(P,B) cvtpk_s(P[B],P[B+1])
  #define PAF(k) __builtin_bit_cast(bf16x8,pw##k)
  #define VFR(i) (bf16x8){vlo[i][0],vlo[i][1],vlo[i][2],vlo[i][3],vhi[i][0],vhi[i][1],vhi[i][2],vhi[i][3]}
  #define PIN(x) asm volatile("":"+v"(x))
  #define MX3(a,b,c) __builtin_fmaxf(__builtin_fmaxf((a),(b)),(c))
  #define GAPA(MF,A0,A1,A2,A3,W0,W1,PW) do{ MF; sacc+=A0; sacc+=A1; sacc+=A2; sacc+=A3; PIN(sacc); W0; W1; PIN(PW); SBAR(); }while(0)
  #define EX(v) __builtin_amdgcn_exp2f(v)
  #define GAPB(MF,X,B) do{ MF; X[B]=EX(X[B]); X[B+1]=EX(X[B+1]); X[B+2]=EX(X[B+2]); X[B+3]=EX(X[B+3]); PIN(X); SBAR(); }while(0)
  #define VRD(i) do{ vlo[i]=vtr(vp_+(((i)>>2)*4096+((i)&3)*1024)); vhi[i]=vtr(vp_+(((i)>>2)*4096+((i)&3)*1024+512)); }while(0)
  #define KRD(G,j) do{ if(G){ kload2(kf,kp0+sl_next,j); SBAR(); } }while(0)
  #define STEP(C0,C1,P0,P1,t,GK,GV,GL) do{ SBAR(); \
    const lds_cptr vp_=vp0+sl_prev; \
    VRD(0); SBAR(); float sacc=(P0[0]+P0[1]); \
    GAPA(C0=__builtin_amdgcn_mfma_f32_32x32x16_bf16(kf[0],qr[0],negm,0,0,0), P0[2],P0[3],P0[4],P0[5],     pw0[0]=PKW(P0,0), pw0[1]=PKW(P0,2), pw0); \
    VRD(4); SBAR(); GAPA(C1=__builtin_amdgcn_mfma_f32_32x32x16_bf16(kf[1],qr[0],negm,0,0,0), P0[6],P0[7],P0[8],P0[9],     pw0[2]=PKW(P0,4), pw0[3]=PKW(P0,6), pw0); \
    VRD(1); SBAR(); GAPA(C0=__builtin_amdgcn_mfma_f32_32x32x16_bf16(kf[2],qr[1],C0,0,0,0),   P0[10],P0[11],P0[12],P0[13], pw1[0]=PKW(P0,8), pw1[1]=PKW(P0,10), pw1); \
    VRD(5); SBAR(); GAPA(C1=__builtin_amdgcn_mfma_f32_32x32x16_bf16(kf[3],qr[1],C1,0,0,0),   P0[14],P0[15],P1[0],P1[1],   pw1[2]=PKW(P0,12),pw1[3]=PKW(P0,14), pw1); \
    VRD(2); SBAR(); GAPA(C0=__builtin_amdgcn_mfma_f32_32x32x16_bf16(kf[4],qr[2],C0,0,0,0),   P1[2],P1[3],P1[4],P1[5],     pw2[0]=PKW(P1,0), pw2[1]=PKW(P1,2), pw2); \
    VRD(6); SBAR(); GAPA(C1=__builtin_amdgcn_mfma_f32_32x32x16_bf16(kf[5],qr[2],C1,0,0,0),   P1[6],P1[7],P1[8],P1[9],     pw2[2]=PKW(P1,4), pw2[3]=PKW(P1,6), pw2); \
    VRD(3); SBAR(); GAPA(C0=__builtin_amdgcn_mfma_f32_32x32x16_bf16(kf[6],qr[3],C0,0,0,0),   P1[10],P1[11],P1[12],P1[13], pw3[0]=PKW(P1,8), pw3[1]=PKW(P1,10), pw3); \
    VRD(7); SBAR(); GAPA(C1=__builtin_amdgcn_mfma_f32_32x32x16_bf16(kf[7],qr[3],C1,0,0,0),   P1[14],P1[15],0.f,0.f,       pw3[2]=PKW(P1,12),pw3[3]=PKW(P1,14), pw3); \
    l_reg+=sacc; \
    if(GK){DMA_K((t)+3,sl_cur);} if(GV){DMA_V((t)+1,sl_next);} \
    CMASK(C0,C1,t); \
    { float a=MX3(C0[0],C0[1],C1[0]),b=MX3(C0[2],C0[3],C1[1]); a=MX3(a,C1[2],C1[3]); \
      _Pragma("unroll") for(int r=4;r<16;r+=4){a=MX3(a,C0[r],C0[r+1]);b=MX3(b,C0[r+2],C0[r+3]);a=MX3(a,C1[r],C1[r+1]);b=MX3(b,C1[r+2],C1[r+3]);} \
      float rm=__builtin_fmaxf(a,b); { auto rr=__builtin_amdgcn_permlane32_swap(__float_as_uint(rm),__float_as_uint(rm),false,false); rm=__builtin_fmaxf(__uint_as_float(rr[0]),__uint_as_float(rr[1])); } \
      resc=false; \
      if(__builtin_expect(__any(rm>(float)THRL),0)){ const float dl=__builtin_fmaxf(rm,0.f); mhat+=dl; \
        _Pragma("unroll") for(int r=0;r<16;++r){C0[r]-=dl;C1[r]-=dl;} \
        _Pragma("unroll") for(int r=0;r<16;++r)negm[r]=-mhat; asm volatile("":"+v"(negm)); \
        const float f=__builtin_amdgcn_exp2f(-dl); l_reg*=f; if(hi==0)wsf[r32]=f; resc=true; } } \
    SBAR(); \
    GAPB(o[0]=__builtin_amdgcn_mfma_f32_32x32x16_bf16(PAF(0),VFR(0),o[0],0,0,0), C0,0); \
    GAPB(o[1]=__builtin_amdgcn_mfma_f32_32x32x16_bf16(PAF(0),VFR(4),o[1],0,0,0), C0,4); \
    KRD(GL,0); GAPB(o[0]=__builtin_amdgcn_mfma_f32_32x32x16_bf16(PAF(1),VFR(1),o[0],0,0,0), C0,8); \
    KRD(GL,1); GAPB(o[1]=__builtin_amdgcn_mfma_f32_32x32x16_bf16(PAF(1),VFR(5),o[1],0,0,0), C0,12); \
    KRD(GL,2); GAPB(o[0]=__builtin_amdgcn_mfma_f32_32x32x16_bf16(PAF(2),VFR(2),o[0],0,0,0), C1,0); \
    KRD(GL,3); GAPB(o[1]=__builtin_amdgcn_mfma_f32_32x32x16_bf16(PAF(2),VFR(6),o[1],0,0,0), C1,4); \
    GAPB(o[0]=__builtin_amdgcn_mfma_f32_32x32x16_bf16(PAF(3),VFR(3),o[0],0,0,0), C1,8); \
    GAPB(o[1]=__builtin_amdgcn_mfma_f32_32x32x16_bf16(PAF(3),VFR(7),o[1],0,0,0), C1,12); \
    }while(0)
  int t=1;
  for(;t+5<NT;t+=2){
    STEP(pB0,pB1,pA0,pA1,t,true,true,true);     WAIT_BAR(2); RESC(); ROT();
    STEP(pA0,pA1,pB0,pB1,t+1,true,true,true);   WAIT_BAR(2); RESC(); ROT();
  }
  #define ENDW(tt) do{ if((tt)+3<NT){WAIT_BAR(2);} else if((tt)+2<NT){WAIT_BAR(1);} else {WAIT_BAR(0);} }while(0)
  for(;t+1<NT;t+=2){
    STEP(pB0,pB1,pA0,pA1,t,(t+3<NT),(t+1<NT),(t+1<NT));       ENDW(t);   RESC(); ROT();
    STEP(pA0,pA1,pB0,pB1,t+1,(t+4<NT),(t+2<NT),(t+2<NT));     ENDW(t+1); RESC(); ROT();
  }
  STEP(pB0,pB1,pA0,pA1,NT-1,false,false,false); RESC();
  { float sacc=pB0[0]+pB0[1]; _Pragma("unroll") for(int r=2;r<16;++r)sacc+=pB0[r]; _Pragma("unroll") for(int r=0;r<16;++r)sacc+=pB1[r]; l_reg+=sacc;
    pw0=(u32x4){PKW(pB0,0),PKW(pB0,2),PKW(pB0,4),PKW(pB0,6)};pw1=(u32x4){PKW(pB0,8),PKW(pB0,10),PKW(pB0,12),PKW(pB0,14)};pw2=(u32x4){PKW(pB1,0),PKW(pB1,2),PKW(pB1,4),PKW(pB1,6)};pw3=(u32x4){PKW(pB1,8),PKW(pB1,10),PKW(pB1,12),PKW(pB1,14)};
    SBAR(); pv(o,vb0+sl_cur,PAF(0),PAF(1),PAF(2),PAF(3)); }
  #undef PKW
  #undef PAF
  #undef VFR
  #undef PIN
  #undef MX3
  #undef GAPA
  #undef GAPB
  #undef EX
  #undef VRD
  #undef KRD
  #undef STEP
  #undef ENDW
  {auto rr=__builtin_amdgcn_permlane32_swap(__float_as_uint(l_reg),__float_as_uint(l_reg),false,false);l_reg=__uint_as_float(rr[0])+__uint_as_float(rr[1]);}
  if(hi==0)wsf[32+r32]=l_reg;asm volatile("s_waitcnt lgkmcnt(0)":::"memory");
  float rli[16];
  #pragma unroll
  for(int r=0;r<16;++r)rli[r]=__builtin_amdgcn_rcpf(wsf[32+crow(r,hi)]);
  bf16*Ow=Ow0+(long)(wid*QBLK)*QP;
  { bf16*stg=(bf16*)(shm+LDS_OST)+wid*2048;
    #pragma unroll
    for(int r=0;r<16;++r){const int orow=crow(r,hi);
      #pragma unroll
      for(int d0=0;d0<2;++d0)stg[orow*64+d0*32+r32]=__float2bfloat16(o[d0][r]*rli[r]);}
    asm volatile("s_waitcnt lgkmcnt(0)":::"memory");
    #pragma unroll
    for(int i=0;i<4;++i){const int row=i*8+(lane>>3),ch=lane&7; const u32x4 v=*(const u32x4*)(stg+row*64+ch*8); ATTN_STORE16(Ow+(long)row*QP+ch*8,v);} }
  asm volatile("s_waitcnt lgkmcnt(0)\n\ts_barrier":::"memory");
  #undef DMA_K
  #undef DMA_V
  #undef CMASK
  #undef START
  #undef RESC
  #undef ROT
}
constexpr int ATTN_LDS_BYTES=LDS_BYTES;
#undef SBAR
#undef WAIT_BAR
}
constexpr int NWAVES = 8, NTHR = 512;
constexpr int DMODEL = 1024, NBATCH = 8, SEQ = 2048, CTXL = 256, DEPTH = 2;
constexpr int NLAT = NBATCH * SEQ, NCTX = NBATCH * CTXL, MT = NLAT + NCTX;
constexpr int INW = 1536, FF = 2816, NKEY = CTXL + SEQ, KVW = 128, MODW = 6144;
constexpr int O_K = 512, O_V = 640, O_G = 768, O_P = 1280;
constexpr float EPS = 1e-6f;
constexpr size_t MiB = 1u << 20;
constexpr size_t WS_CTL = 0, CTL_ZERO_BYTES = 1 * MiB;
constexpr size_t WS_MOD = 64 * 1024;
constexpr size_t WS_ROPE = 1 * MiB;
constexpr size_t WS_WS = WS_ROPE + 512 * 1024;
constexpr size_t WS_PW = WS_WS + 256 * 1024;
constexpr size_t WS_WIN = 2 * MiB, WS_WOUT = 8 * MiB, WS_WGU = 12 * MiB, WS_WDN = 34 * MiB;
constexpr size_t WS_CTXRES = 45 * MiB;
constexpr size_t WS_H = 53 * MiB;
constexpr size_t WS_ACT = 89 * MiB;
constexpr size_t WS_Z = 89 * MiB, WS_MIX = 143 * MiB, WS_KB = 179 * MiB, WS_VB = WS_KB + 4608 * 1024;
constexpr size_t WS_BIAS = 188 * MiB;
constexpr size_t WS_END = 189 * MiB;
constexpr size_t WS_SLAB = 192 * MiB; constexpr int KSPLIT = 4;
constexpr size_t WS_XH = 224 * MiB;
static_assert(WS_SLAB + (size_t)32 * KSPLIT * 65536 * 4 <= WS_XH && WS_XH + (size_t)NLAT * DMODEL * 2 <= 256 * MiB, "slabs / fp16 stream inside 256 MiB");
constexpr size_t WS_RSSV = 872 * 1024;
constexpr size_t WS_RSS = 512 * 1024;
static_assert((4096 + 3456) * 4 <= 64 * 1024, "barrier words below the mod accumulators");
static_assert(WS_MOD + (size_t)DEPTH * 9 * MODW * 4 <= WS_RSS && WS_RSS + (size_t)5 * MT * 4 <= WS_RSSV && WS_RSSV + (size_t)DEPTH * MT * 4 <= CTL_ZERO_BYTES, "mod / rss inside memset region");
static_assert(WS_Z + (size_t)MT * INW * 2 <= WS_MIX && WS_MIX + (size_t)MT * 1024 * 2 <= WS_KB && WS_VB + (size_t)NBATCH * NKEY * KVW * 2 <= WS_END && WS_ACT + (size_t)MT * FF * 2 <= WS_END, "ws map");
static_assert(WS_WIN + (size_t)DEPTH * INW * 1024 * 2 <= WS_WOUT && WS_WOUT + (size_t)DEPTH * 1024 * 1024 * 2 <= WS_WGU && WS_WGU + (size_t)DEPTH * 2 * FF * 1024 * 2 <= WS_WDN && WS_WDN + (size_t)DEPTH * 1024 * FF * 2 <= WS_CTXRES, "ws map 2");
constexpr int LDSCTL_OFF = 131072, MISC_OFF = LDSCTL_OFF + 320;
constexpr int LDS_BYTES = 147456;

#define LAS __attribute__((address_space(3)))
typedef unsigned short bf16;
typedef unsigned v4u __attribute__((ext_vector_type(4)));
typedef unsigned v2u __attribute__((ext_vector_type(2)));
typedef float f32x4 __attribute__((ext_vector_type(4)));
typedef short bf16x8 __attribute__((ext_vector_type(8)));
#define LDS_WAIT() asm volatile("s_waitcnt lgkmcnt(0)" ::: "memory")
__device__ __forceinline__ unsigned f2bf(float f) { unsigned u = __builtin_bit_cast(unsigned, f); return (u + 0x7fffu + ((u >> 16) & 1u)) >> 16; }
__device__ __forceinline__ unsigned pk2(float lo, float hi) { return f2bf(lo) | (f2bf(hi) << 16); }
__device__ __forceinline__ float bflo(unsigned w) { return __builtin_bit_cast(float, w << 16); }
__device__ __forceinline__ float bfhi(unsigned w) { return __builtin_bit_cast(float, w & 0xffff0000u); }
__device__ __forceinline__ void unpack8(const v4u r, float (&f)[8]) { f[0] = bflo(r.x); f[1] = bfhi(r.x); f[2] = bflo(r.y); f[3] = bfhi(r.y); f[4] = bflo(r.z); f[5] = bfhi(r.z); f[6] = bflo(r.w); f[7] = bfhi(r.w); }
__device__ __forceinline__ v4u pack8(const float (&f)[8]) { v4u o; o.x = pk2(f[0], f[1]); o.y = pk2(f[2], f[3]); o.z = pk2(f[4], f[5]); o.w = pk2(f[6], f[7]); return o; }
__device__ __forceinline__ float wave_sum(float v) {
#pragma unroll
    for (int o = 1; o < 64; o <<= 1) v += __shfl_xor(v, o);
    return v;
}
__device__ __forceinline__ float gelu_tanh(float x) {
    const float y = 0.7978845608028654f * (x + 0.044715f * x * x * x);
    const float e = __builtin_amdgcn_exp2f(y * -2.8853900817779268f);
    return x * __builtin_amdgcn_rcpf(1.0f + e);
}

#define RLX_AGENT __ATOMIC_RELAXED, __HIP_MEMORY_SCOPE_AGENT
#define XB_TMO      128
#define XB_XCNT(j)  (256  + 64 * (j))
#define XB_XSUB(j)  (1280 + 64 * (j))
#define XB_XGEN(j)  (2304 + 64 * (j))
#define XB_TOP      3328
#define XB_TOPGEN   3392
#define XCD_BAR_WORDS 3456
#define XB_SPIN_CAP (1u << 18)

__device__ __forceinline__ unsigned xb_ld(unsigned* p)              { return __hip_atomic_load(p, __ATOMIC_RELAXED, __HIP_MEMORY_SCOPE_AGENT); }
__device__ __forceinline__ unsigned xb_add(unsigned* p, unsigned v) { return __hip_atomic_fetch_add(p, v, __ATOMIC_RELAXED, __HIP_MEMORY_SCOPE_AGENT); }
__device__ __forceinline__ unsigned xb_xcc_id() { return (unsigned)__builtin_amdgcn_s_getreg((3 << 11) | 20) & 0xFu; }
#define XB_SPIN(cond, bar) do { unsigned _sp = 0; while (cond) { __builtin_amdgcn_s_sleep(1); \
    if ((++_sp & 255u) == 0u) { if (xb_ld(&(bar)[XB_TMO])) break; if (_sp > XB_SPIN_CAP) { atomicAdd(&(bar)[XB_TMO], 1u); break; } } } } while (0)

struct XcdBarrier {
    unsigned* bar; unsigned x;
    volatile LAS unsigned* st;
};

__device__ __forceinline__ XcdBarrier xcd_barrier_post(unsigned* bar, volatile LAS unsigned* st) {
    XcdBarrier b; b.bar = bar; b.x = xb_xcc_id(); b.st = st;
    if (threadIdx.x == 0) (void)xb_add(&bar[XB_XCNT(b.x)], 1u);
    return b;
}
__device__ __forceinline__ void xcd_barrier_complete(unsigned* bar, unsigned x, unsigned& nloc, unsigned& nx) {
    const unsigned G = gridDim.x * gridDim.y * gridDim.z;
    unsigned sum, cnt, mine, sp = 0u;
    for (;;) {
        sum = 0u; cnt = 0u; mine = 0u;
#pragma unroll
        for (unsigned j = 0; j < 16; ++j) { const unsigned c = xb_ld(&bar[XB_XCNT(j)]); sum += c; cnt += (c > 0u) ? 1u : 0u; mine = (j == x) ? c : mine; }
        if (sum == G) break;
        __builtin_amdgcn_s_sleep(1);
        if ((++sp & 255u) == 0u) { if (xb_ld(&bar[XB_TMO])) break; if (sp > XB_SPIN_CAP) { atomicAdd(&bar[XB_TMO], 1u); break; } }
    }
    nloc = mine > 0u ? mine : 1u; nx = cnt > 0u ? cnt : 1u;
}

__device__ __forceinline__ void xcd_barrier(const XcdBarrier& b) {
    asm volatile("s_waitcnt vmcnt(0)" ::: "memory");
    __syncthreads();
    if (threadIdx.x == 0) {
        unsigned* bar = b.bar;
        __builtin_amdgcn_s_waitcnt(0);
        unsigned nloc = b.st[0], nx = b.st[1];
        if (nloc == 0u) { xcd_barrier_complete(bar, b.x, nloc, nx); b.st[0] = nloc; b.st[1] = nx; }
        const unsigned old = xb_add(&bar[XB_XSUB(b.x)], 1u);
        const unsigned gen = old / nloc;
        if (old + 1u == (gen + 1u) * nloc) {
            __builtin_amdgcn_fence(__ATOMIC_RELEASE, "agent");
            asm volatile("s_waitcnt vmcnt(0)" ::: "memory");
            const unsigned og = xb_add(&bar[XB_TOP], 1u);
            const unsigned tg = og / nx;
            if (og + 1u == (tg + 1u) * nx) xb_add(&bar[XB_TOPGEN], 1u);
            else XB_SPIN(xb_ld(&bar[XB_TOPGEN]) == tg, bar);
            __builtin_amdgcn_fence(__ATOMIC_ACQUIRE, "agent");
            xb_add(&bar[XB_XGEN(b.x)], 1u);
            asm volatile("s_waitcnt vmcnt(0)" ::: "memory");
        } else {
            XB_SPIN(xb_ld(&bar[XB_XGEN(b.x)]) == gen, bar);
            __builtin_amdgcn_fence(__ATOMIC_ACQUIRE, "agent");
            asm volatile("s_waitcnt vmcnt(0)" ::: "memory");
        }
    }
    __syncthreads();
}

constexpr int CW_PANEL = 8192;
constexpr int CW_BAR = 4096;
struct Args { const float* in[21]; float* out; unsigned char* ws; unsigned long long pad; };
struct Frame {
    LAS unsigned char* lds;
    int tid, lane, wave, vcu, G;
    float* out; unsigned char* ws;
};

__device__ __forceinline__ void relaunder(Frame& F) { int t = threadIdx.x; asm volatile("" : "+v"(t)); F.tid = t; F.lane = t & 63; F.wave = __builtin_amdgcn_readfirstlane(t >> 6); }
__device__ __forceinline__ void p0_transpose_item(const float* W, int K, int N, bf16* WT, int k0, int n0, int drow0, LAS float* scr, int lane) {
    float tv[32];
#pragma unroll
    for (int i = 0; i < 32; ++i) tv[i] = __builtin_nontemporal_load(&W[(size_t)(k0 + 2 * i + (lane >> 5)) * N + n0 + (lane & 31)]);
#pragma unroll
    for (int i = 0; i < 32; ++i) scr[(2 * i + (lane >> 5)) * 33 + (lane & 31)] = tv[i];
    LDS_WAIT(); asm volatile("" ::: "memory");
    const int c = lane & 7;
#pragma unroll
    for (int j = 0; j < 4; ++j) { const int n = (lane >> 3) + 8 * j; const LAS float* s = scr + (8 * c) * 33 + n;
        v4u o; o.x = pk2(s[0 * 33], s[1 * 33]); o.y = pk2(s[2 * 33], s[3 * 33]); o.z = pk2(s[4 * 33], s[5 * 33]); o.w = pk2(s[6 * 33], s[7 * 33]);
        *(v4u*)(WT + (size_t)(drow0 + n) * K + k0 + 8 * c) = o; }
    LDS_WAIT(); asm volatile("" ::: "memory");
}
__device__ __forceinline__ void transpose_set(const Args& A, Frame& F, int set, int widx, int nw) {
    LAS float* scr = (LAS float*)(F.lds + F.wave * 16384);
    constexpr int I_IN = 16 * 48, I_OUT = 16 * 32, I_G = 16 * 88, I_D = 44 * 32;
    const int total = set == 0 ? 2 * I_IN + I_OUT : set == 1 ? 2 * I_G + I_D + I_OUT : 2 * I_G + I_D;
    for (int it = widx; it < total; it += nw) {
        int r = it, kind, l;
        if (set == 0) { if (r < 2 * I_IN) { kind = 0; l = r / I_IN; r %= I_IN; } else { kind = 1; l = 0; r -= 2 * I_IN; } }
        else { l = set - 1; if (r < 2 * I_G) kind = 2; else if (r < 2 * I_G + I_D) { kind = 3; r -= 2 * I_G; } else { kind = 1; l = 1; r -= 2 * I_G + I_D; } }
        if (kind == 0) { const int kb = r / 48, nb = r % 48; p0_transpose_item(A.in[8] + (size_t)l * 1024 * INW, 1024, INW, (bf16*)(F.ws + WS_WIN) + (size_t)l * INW * 1024, 64 * kb, 32 * nb, 32 * nb, scr, F.lane); }
        else if (kind == 1) { const int kb = r / 32, nb = r % 32; p0_transpose_item(A.in[16] + (size_t)l * 1024 * 1024, 1024, 1024, (bf16*)(F.ws + WS_WOUT) + (size_t)l * 1024 * 1024, 64 * kb, 32 * nb, 32 * nb, scr, F.lane); }
        else if (kind == 2) { const int up = r >= I_G; if (up) r -= I_G; const int kb = r / 88, nb = r % 88, n0 = 32 * nb;
            p0_transpose_item(A.in[up ? 18 : 17] + (size_t)l * 1024 * FF, 1024, FF, (bf16*)(F.ws + WS_WGU) + (size_t)l * 2 * FF * 1024, 64 * kb, n0, 256 * (n0 >> 7) + (n0 & 127) + (up ? 128 : 0), scr, F.lane); }
        else { const int kb = r / 32, nb = r % 32; p0_transpose_item(A.in[19] + (size_t)l * FF * 1024, FF, 1024, (bf16*)(F.ws + WS_WDN) + (size_t)l * 1024 * FF, 64 * kb, 32 * nb, 32 * nb, scr, F.lane); }
    }
}
__device__ __forceinline__ void tail_transposes(const Args& A, Frame& F, int set, int nwg) {
    relaunder(F);
    const int G = F.G, rounds = (nwg + G - 1) / G; int first_idle = nwg - G * (rounds - 1); if (first_idle >= G) first_idle = 0;
    if ((int)blockIdx.x >= first_idle) transpose_set(A, F, set, ((int)blockIdx.x - first_idle) * NWAVES + F.wave, (G - first_idle) * NWAVES);
}
__device__ __forceinline__ void p0_prologue(const Args& A, Frame& F) {
    relaunder(F);
    const int gw = F.vcu * NWAVES + F.wave, NGW = F.G * NWAVES;
    const int gt = F.vcu * NTHR + F.tid, NGT = F.G * NTHR;
    LAS float* S = (LAS float*)F.lds;
    {   f32x4 cv[5];
#pragma unroll
        for (int i = 0; i < 5; ++i) { const int q = min(F.tid + NTHR * i, 2303); cv[i] = q < 2048 ? *(const f32x4*)(A.in[1] + 4 * q) : *(const f32x4*)(A.in[3] + 4 * (q - 2048)); }
#pragma unroll
        for (int i = 0; i < 5; ++i) { const int q = F.tid + NTHR * i; if (q < 2304) { f32x4 o;
#pragma unroll
            for (int e = 0; e < 4; ++e) o[e] = cv[i][e] * __builtin_amdgcn_rcpf(1.0f + __builtin_amdgcn_exp2f(cv[i][e] * -1.4426950408889634f));
            *(LAS f32x4*)(S + 4 * q) = o; } }
    }
    __syncthreads();
    float* mod = (float*)(F.ws + WS_MOD);
    constexpr int MOD_KS = 16, MOD_KL = 1024 / MOD_KS, MOD_ITEMS = DEPTH * (MODW / 64) * MOD_KS;
    for (int it = gw; it < MOD_ITEMS; it += NGW) {
        const int ks = it % MOD_KS, cgp = (it / MOD_KS) % (MODW / 64), l = it / (MOD_KS * (MODW / 64));
        const int n = cgp * 64 + F.lane, k0 = ks * MOD_KL;
        const float* wp = A.in[4] + (size_t)l * 1024 * MODW + (size_t)k0 * MODW + n;
        float a[9];
#pragma unroll
        for (int r = 0; r < 9; ++r) a[r] = 0.f;
#pragma unroll 16
        for (int kk = 0; kk < MOD_KL; ++kk) { const float w = __builtin_nontemporal_load(&wp[(size_t)kk * MODW]);
#pragma unroll
            for (int r = 0; r < 9; ++r) a[r] += S[r * 1024 + k0 + kk] * w; }
        if (ks == 0) { const float bv = A.in[5][l * MODW + n];
#pragma unroll
            for (int r = 0; r < 9; ++r) a[r] += bv; }
#pragma unroll
        for (int r = 0; r < 9; ++r) atomicAdd(mod + ((size_t)l * 9 + r) * MODW + n, a[r]);
    }
    __syncthreads();
    float* rc = (float*)(F.ws + WS_ROPE); float* rs = rc + SEQ * 32;
    for (int i = gt; i < SEQ * 32; i += NGT) { const int tok = i >> 5, p = i & 31; const float pos = (float)(p < 16 ? (tok >> 6) : (tok & 63));
        const float inv = exp2f(-(float)(p & 15) * (13.287712379549449f / 16.0f));
        const float ang = pos * inv; const float nrev = rintf(ang * 0.15915494309189535f);
        float r = fmaf(-nrev, 6.2831855f, ang); r = fmaf(-nrev, -1.7484555e-7f, r);
        rc[i] = __cosf(r); rs[i] = __sinf(r); }
    bf16* wsb = (bf16*)(F.ws + WS_WS);
    for (int i = gt; i < DEPTH * 4 * 128 * 128; i += NGT) wsb[i] = (bf16)f2bf(A.in[12][i]);
    bf16* pwb = (bf16*)(F.ws + WS_PW);
    for (int i = gt; i < DEPTH * 4 * 64 * 64; i += NGT) { const int c = i & 63, d = (i >> 6) & 63, lg = i >> 12; pwb[i] = (bf16)f2bf(A.in[14][(size_t)lg * 4096 + c * 64 + d]); }
    transpose_set(A, F, 0, gw, NGW);
}

__device__ __forceinline__ void norm_phase(Frame& F, const float* lat, const float* ctx, int nrows, const float* g, const float* modl, int sc_off, bf16* H, float* rss) {
    relaunder(F);
    const int gw = F.vcu * NWAVES + F.wave, NGW = F.G * NWAVES;
    for (int row = gw; row < nrows; row += NGW) {
        const bool isl = row < NLAT; const int b = isl ? (row >> 11) : 8;
        const f32x4* xr = (const f32x4*)(isl ? lat + (size_t)row * DMODEL : ctx + (size_t)(row - NLAT) * DMODEL) + F.lane;
        f32x4 v[4]; float s = 0.f;
#pragma unroll
        for (int j = 0; j < 4; ++j) { v[j] = __builtin_nontemporal_load(xr + 64 * j); s += (v[j].x * v[j].x + v[j].y * v[j].y) + (v[j].z * v[j].z + v[j].w * v[j].w); }
        s = wave_sum(s);
        if (F.lane == 0) rss[row] = s;
        const f32x4* g4 = (const f32x4*)g + F.lane; const f32x4* sc4 = (const f32x4*)(modl + (size_t)b * MODW + sc_off) + F.lane;
        v2u* o8 = (v2u*)(H + (size_t)row * DMODEL) + F.lane;
#pragma unroll
        for (int j = 0; j < 4; ++j) { const f32x4 y = v[j] * g4[64 * j] * (sc4[64 * j] + 1.0f); v2u o; o.x = pk2(y.x, y.y); o.y = pk2(y.z, y.w); o8[64 * j] = o; }
    }
}
__device__ __forceinline__ void ctx_combine_phase(Frame& F, const float* slabs, const float* base_ctx, float* out_ctx, const float* gate, const float* gn, const float* scn, bf16* H, float* rss) {
    relaunder(F);
    const int gw = F.vcu * NWAVES + F.wave, NGW = F.G * NWAVES, lane = F.lane;
    for (int R = gw; R < NCTX; R += NGW) {
        const int pmc = R >> 8, r = R & 255;
        f32x4 sv[4][KSPLIT], bv[4];
#pragma unroll
        for (int j = 0; j < 4; ++j) { bv[j] = *(const f32x4*)(base_ctx + (size_t)R * DMODEL + 256 * j + 4 * lane);
#pragma unroll
            for (int q = 0; q < KSPLIT; ++q) sv[j][q] = *(const f32x4*)(slabs + (size_t)((j * 8 + pmc) * KSPLIT + q) * 65536 + (size_t)r * 256 + 4 * lane); }
        float ss = 0.f; f32x4 x[4];
#pragma unroll
        for (int j = 0; j < 4; ++j) { f32x4 a = sv[j][0];
#pragma unroll
            for (int q = 1; q < KSPLIT; ++q) a += sv[j][q];
            x[j] = bv[j] + *(const f32x4*)(gate + 8 * MODW + 256 * j + 4 * lane) * a;
            ss += (x[j].x * x[j].x + x[j].y * x[j].y) + (x[j].z * x[j].z + x[j].w * x[j].w); }
        ss = wave_sum(ss);
        if (lane == 0) rss[NLAT + R] = ss;
#pragma unroll
        for (int j = 0; j < 4; ++j) { const int c = 256 * j + 4 * lane; *(f32x4*)(out_ctx + (size_t)R * DMODEL + c) = x[j];
            const f32x4 y = x[j] * *(const f32x4*)(gn + c) * (*(const f32x4*)(scn + 8 * MODW + c) + 1.0f); v2u o; o.x = pk2(y.x, y.y); o.y = pk2(y.z, y.w); *(v2u*)(H + (size_t)(NLAT + R) * DMODEL + c) = o; }
    }
}
__device__ __forceinline__ void bias_phase(Frame& F, const float* mod, int sel) {
    relaunder(F);
    LAS bf16* S = (LAS bf16*)F.lds;
    constexpr int SP = 1032;
    {
        f32x4 tv[18];
#pragma unroll
        for (int i = 0; i < 18; ++i) { const int q = F.tid + NTHR * i, row = q >> 8, c4 = q & 255, tb = row / 9, r = row % 9;
            tv[i] = *(const f32x4*)(mod + (size_t)(tb >> 1) * 9 * MODW + (size_t)r * MODW + ((tb & 1) ? 3072 : 0) + 4 * c4); }
#pragma unroll
        for (int i = 0; i < 18; ++i) { const int q = F.tid + NTHR * i, row = q >> 8, c4 = q & 255, tb = row / 9, r = row % 9;
            v2u o; o.x = pk2(tv[i].x, tv[i].y); o.y = pk2(tv[i].z, tv[i].w); *(LAS v2u*)(S + (tb * 10 + r) * SP + 4 * c4) = o; }
#pragma unroll
        for (int i = 0; i < 2; ++i) { const int q = F.tid + NTHR * i, tb = q >> 8, c4 = q & 255; *(LAS v2u*)(S + (tb * 10 + 9) * SP + 4 * c4) = (v2u){0u, 0u}; }
    }
    __syncthreads();
    const int gw = F.vcu * NWAVES + F.wave, NGW = F.G * NWAVES, lane = F.lane, fr = lane & 15, fq = lane >> 4;
    constexpr int IT_IN = INW / 16, IT_GU = 2 * FF / 16;
    const int nit = sel < 0 ? DEPTH * IT_IN : IT_GU;
    for (int it = gw; it < nit; it += NGW) {
        const int gu = sel >= 0, l = gu ? sel : it / IT_IN; int r = gu ? it : it % IT_IN; const int NR = gu ? 2 * FF : INW;
        const bf16* Wt = (gu ? (const bf16*)(F.ws + WS_WGU) + (size_t)l * 2 * FF * 1024 : (const bf16*)(F.ws + WS_WIN) + (size_t)l * INW * 1024) + (size_t)(16 * r + fr) * 1024 + 8 * fq;
        const LAS bf16* Sp = S + ((l * 2 + gu) * 10 + (fr < 9 ? fr : 9)) * SP + 8 * fq;
        f32x4 acc = (f32x4){0.f, 0.f, 0.f, 0.f};
#pragma unroll 8
        for (int kk = 0; kk < 32; ++kk) { const bf16x8 a = *(const LAS bf16x8*)(Sp + 32 * kk); const bf16x8 bfr = *(const bf16x8*)(Wt + 32 * kk); acc = __builtin_amdgcn_mfma_f32_16x16x32_bf16(a, bfr, acc, 0, 0, 0); }
        float* bo = (float*)(F.ws + WS_BIAS) + (gu ? (size_t)DEPTH * 9 * INW + (size_t)l * 9 * 2 * FF : (size_t)l * 9 * INW);
#pragma unroll
        for (int i = 0; i < 4; ++i) { const int rr = 4 * fq + i; if (rr < 9) bo[(size_t)rr * NR + 16 * r + fr] = acc[i]; }
    }
    __syncthreads();
}
__device__ __forceinline__ void final_norm_phase(Frame& F, const unsigned short* xh, float* out, const float* g) {
    relaunder(F);
    const int gw = F.vcu * NWAVES + F.wave, NGW = F.G * NWAVES;
    for (int row = gw; row < NLAT; row += NGW) {
        f32x4 v[4];
#pragma unroll
        for (int j = 0; j < 2; ++j) { const v4u w = *(const v4u*)(xh + (size_t)row * DMODEL + 512 * j + 8 * F.lane); pg8::unpack_h8(w, v[2 * j], v[2 * j + 1]); }
        float s = 0.f;
#pragma unroll
        for (int j = 0; j < 4; ++j) s += (v[j].x * v[j].x + v[j].y * v[j].y) + (v[j].z * v[j].z + v[j].w * v[j].w);
        const float rstd = 1.0f / sqrtf(wave_sum(s) * (1.f / DMODEL) + EPS);
#pragma unroll
        for (int j = 0; j < 2; ++j) { const int c = 512 * j + 8 * F.lane; float* o = out + (size_t)row * DMODEL + c;
            *(f32x4*)o = (v[2 * j] * rstd) * *(const f32x4*)(g + c); *(f32x4*)(o + 4) = (v[2 * j + 1] * rstd) * *(const f32x4*)(g + c + 4); }
    }
}

__device__ __forceinline__ void prep_qkv(const Args& A, Frame& F, int l, const bf16* Z, bf16* MIX, bf16* KB, bf16* VB) {
    relaunder(F);
    const int gw = F.vcu * NWAVES + F.wave, NGW = F.G * NWAVES, lane = F.lane;
    const float* rc = (const float*)(F.ws + WS_ROPE); const float* rs = rc + SEQ * 32;
    const int j = lane & 7;
    float qn_[8], kn_[8];
#pragma unroll
    for (int e = 0; e < 8; ++e) { qn_[e] = A.in[9][l * 64 + 8 * j + e]; kn_[e] = A.in[10][l * 64 + 8 * j + e]; }
    const float sgn = (j < 4) ? -1.f : 1.f;
    for (int rowb = gw; rowb < MT; rowb += 3 * NGW) {
        v4u rq[3], rk[3]; f32x4 c0[3], c1[3], s0[3], s1[3];
#pragma unroll
        for (int q = 0; q < 3; ++q) { const int row = min(rowb + q * NGW, MT - 1); const bool isl = row < NLAT; const int t = isl ? (row & 2047) : 0;
            const bf16* zr = Z + (size_t)row * INW;
            rq[q] = *(const v4u*)(zr + 8 * lane); rk[q] = *(const v4u*)(zr + O_K + 8 * (lane & 31));
            const f32x4* c4 = (const f32x4*)(rc + t * 32 + 8 * (j & 3)); const f32x4* s4 = (const f32x4*)(rs + t * 32 + 8 * (j & 3));
            c0[q] = c4[0]; c1[q] = c4[1]; s0[q] = s4[0]; s1[q] = s4[1]; }
#pragma unroll
        for (int q = 0; q < 3; ++q) { const int row = rowb + q * NGW; if (row < MT) {
            const bool isl = row < NLAT; const int b = isl ? (row >> 11) : ((row - NLAT) >> 8); const int t = isl ? (row & 2047) : ((row - NLAT) & 255);
            float cs[8], sn[8];
            cs[0] = c0[q].x; cs[1] = c0[q].y; cs[2] = c0[q].z; cs[3] = c0[q].w; cs[4] = c1[q].x; cs[5] = c1[q].y; cs[6] = c1[q].z; cs[7] = c1[q].w;
            sn[0] = s0[q].x; sn[1] = s0[q].y; sn[2] = s0[q].z; sn[3] = s0[q].w; sn[4] = s1[q].x; sn[5] = s1[q].y; sn[6] = s1[q].z; sn[7] = s1[q].w;
            if (!isl) {
#pragma unroll
                for (int e = 0; e < 8; ++e) { cs[e] = 1.f; sn[e] = 0.f; } }
            { float f[8]; unpack8(rq[q], f); float ss = 0.f;
#pragma unroll
                for (int e = 0; e < 8; ++e) ss += f[e] * f[e];
                ss += __shfl_xor(ss, 1); ss += __shfl_xor(ss, 2); ss += __shfl_xor(ss, 4);
                const float rstd = 1.0f / sqrtf(ss * (1.f / 64.f) + EPS);
                float o[8];
#pragma unroll
                for (int e = 0; e < 8; ++e) { const float a = f[e] * rstd * qn_[e]; const float pv = __shfl_xor(a, 4); o[e] = (a * cs[e] + sgn * pv * sn[e]) * attn_body::C2; }
                *(v4u*)(MIX + (size_t)row * 1024 + 8 * lane) = pack8(o); }
            { float f[8]; unpack8(rk[q], f); float ss = 0.f;
#pragma unroll
                for (int e = 0; e < 8; ++e) ss += f[e] * f[e];
                ss += __shfl_xor(ss, 1); ss += __shfl_xor(ss, 2); ss += __shfl_xor(ss, 4);
                const float rstd = 1.0f / sqrtf(ss * (1.f / 64.f) + EPS);
                float o[8];
#pragma unroll
                for (int e = 0; e < 8; ++e) { const float a = f[e] * rstd * kn_[e]; const float pv = __shfl_xor(a, 4); o[e] = a * cs[e] + sgn * pv * sn[e]; }
                const size_t krow = ((size_t)b * NKEY + (isl ? CTXL + t : t)) * KVW;
                if (lane < 16) *(v4u*)(KB + krow + 8 * lane) = pack8(o);
                else if (lane < 32) *(v4u*)(VB + krow + 8 * (lane - 16)) = rk[q]; } } }
    }
}
__device__ __forceinline__ void sgu_item(const Args& A, Frame& F, int l, int ci, int hg, const bf16* Z, bf16* MIX, const float* rssv) {
    relaunder(F);
    const int tid = F.tid, lane = F.lane, wave = F.wave, fr = lane & 15, fq = lane >> 4;
    LAS bf16* vT = (LAS bf16*)F.lds;
    LAS float* U = (LAS float*)(F.lds + 17408);
    LAS bf16* OUT = (LAS bf16*)(F.lds + 17408 + 34816);
    const int row0 = ci * 128;
    const int r = tid >> 2, qd = tid & 3; const bf16* zr = Z + (size_t)(row0 + r) * INW + O_G;
    v4u vg[2], uu[2];
#pragma unroll
    for (int i = 0; i < 2; ++i) { vg[i] = *(const v4u*)(zr + 256 + 64 * hg + 16 * qd + 8 * i); uu[i] = *(const v4u*)(zr + 64 * hg + 16 * qd + 8 * i); }
    const float ssv = rssv[row0 + r];
    const bf16* wsb = (const bf16*)(F.ws + WS_WS) + ((size_t)(l * 4 + hg) * 128 + 16 * wave + fr) * 128 + 8 * fq;
    bf16x8 af[4];
#pragma unroll
    for (int kk = 0; kk < 4; ++kk) af[kk] = *(const bf16x8*)(wsb + 32 * kk);
    const float* gn = A.in[11] + l * 256 + 64 * hg + 16 * qd;
    float gnv[16];
#pragma unroll
    for (int e = 0; e < 16; ++e) gnv[e] = gn[e];
    const float* bs = A.in[13] + (size_t)(l * 4 + hg) * 128 + 16 * wave + 4 * fq;
    float bsv[4];
#pragma unroll
    for (int i = 0; i < 4; ++i) bsv[i] = bs[i];
    {   const float rstd = 1.0f / sqrtf(ssv * (1.f / 256.f) + EPS);
#pragma unroll
        for (int i = 0; i < 2; ++i) { float f[8]; unpack8(vg[i], f);
#pragma unroll
            for (int e = 0; e < 8; ++e) vT[(16 * qd + 8 * i + e) * 136 + r] = (bf16)f2bf(f[e] * rstd * gnv[8 * i + e]); }
#pragma unroll
        for (int i = 0; i < 2; ++i) { float f[8]; unpack8(uu[i], f);
            *(LAS f32x4*)(U + r * 68 + 16 * qd + 8 * i) = (f32x4){f[0], f[1], f[2], f[3]};
            *(LAS f32x4*)(U + r * 68 + 16 * qd + 8 * i + 4) = (f32x4){f[4], f[5], f[6], f[7]}; }
    }
    __syncthreads();
    {   f32x4 acc[4];
#pragma unroll
        for (int n = 0; n < 4; ++n) acc[n] = (f32x4){0.f, 0.f, 0.f, 0.f};
#pragma unroll
        for (int kk = 0; kk < 4; ++kk)
#pragma unroll
            for (int n = 0; n < 4; ++n) { const bf16x8 bfr = *(const LAS bf16x8*)(vT + (16 * n + fr) * 136 + 32 * kk + 8 * fq); acc[n] = __builtin_amdgcn_mfma_f32_16x16x32_bf16(af[kk], bfr, acc[n], 0, 0, 0); }
#pragma unroll
        for (int i = 0; i < 4; ++i) { const int p = 16 * wave + 4 * fq + i;
#pragma unroll
            for (int n = 0; n < 4; ++n) OUT[p * 72 + 16 * n + fr] = (bf16)f2bf(U[p * 68 + 16 * n + fr] * (acc[n][i] + bsv[i])); }
    }
    __syncthreads();
    {   const int p = tid >> 2, c = (tid & 3) * 16;
        const v4u o0 = *(const LAS v4u*)(OUT + p * 72 + c), o1 = *(const LAS v4u*)(OUT + p * 72 + c + 8);
        bf16* dst = MIX + (size_t)(row0 + p) * 1024 + 512 + 64 * hg + c; *(v4u*)dst = o0; *(v4u*)(dst + 8) = o1; }
    __syncthreads();
}
template <int G> __device__ __forceinline__ void pool_item(const Args& A, Frame& F, int l, int ci, const bf16* Z, bf16* MIX) {
    relaunder(F);
    constexpr int W = 2 << G, HALFW = W / 2;
    const int tid = F.tid, lane = F.lane, wave = F.wave, fr = lane & 15, fq = lane >> 4;
    LAS bf16* Dm = (LAS bf16*)F.lds;
    LAS bf16* OUT = (LAS bf16*)(F.lds + 18432);
    const int row0 = ci * 128;
    const int seq0 = ci < 128 ? (ci >> 4) * SEQ : NLAT + ((ci - 128) >> 1) * CTXL, N = ci < 128 ? SEQ : CTXL;
    const bf16* pwb = (const bf16*)(F.ws + WS_PW) + (size_t)(l * 4 + G) * 4096;
    float psc[4];
#pragma unroll
    for (int n = 0; n < 4; ++n) psc[n] = A.in[15][l * 256 + 64 * G + 16 * n + fr];
    {   const int r = tid >> 2, qd = tid & 3; const int t = row0 + r - seq0;
        const bf16* zc = Z + (size_t)seq0 * INW + O_P + 64 * G + 16 * qd;
        float sum[16], pc[16];
#pragma unroll
        for (int e = 0; e < 16; ++e) { sum[e] = 0.f; pc[e] = 0.f; }
        constexpr int BT = W < 8 ? W : 8;
#pragma unroll
        for (int j0 = 0; j0 < W; j0 += BT) {
            v4u ra[BT], rb[BT];
#pragma unroll
            for (int jj = 0; jj < BT; ++jj) { const int tj = t - HALFW + j0 + jj; const int tc = min(max(tj, 0), N - 1); ra[jj] = *(const v4u*)(zc + (size_t)tc * INW); rb[jj] = *(const v4u*)(zc + (size_t)tc * INW + 8); }
#pragma unroll
            for (int jj = 0; jj < BT; ++jj) { const int tj = t - HALFW + j0 + jj; const float wgt = (tj >= 0 && tj < N) ? 1.f : 0.f; float f0[8], f1[8]; unpack8(ra[jj], f0); unpack8(rb[jj], f1);
#pragma unroll
                for (int e = 0; e < 8; ++e) { sum[e] += wgt * f0[e]; sum[8 + e] += wgt * f1[e]; if (j0 + jj == HALFW) { pc[e] = f0[e]; pc[8 + e] = f1[e]; } } }
        }
        const int lo = max(t - HALFW, 0), hi = min(t - HALFW + W, N);
        const float rcnt = 1.0f / (float)(hi - lo);
        float d0[8], d1[8];
#pragma unroll
        for (int e = 0; e < 8; ++e) { d0[e] = sum[e] * rcnt - pc[e]; d1[e] = sum[8 + e] * rcnt - pc[8 + e]; }
        *(LAS v4u*)(Dm + r * 72 + 16 * qd) = pack8(d0); *(LAS v4u*)(Dm + r * 72 + 16 * qd + 8) = pack8(d1);
    }
    bf16x8 bfr[2][4];
#pragma unroll
    for (int kk = 0; kk < 2; ++kk)
#pragma unroll
        for (int n = 0; n < 4; ++n) bfr[kk][n] = *(const bf16x8*)(pwb + (16 * n + fr) * 64 + 32 * kk + 8 * fq);
    __syncthreads();
    {   f32x4 acc[4];
#pragma unroll
        for (int n = 0; n < 4; ++n) acc[n] = (f32x4){0.f, 0.f, 0.f, 0.f};
#pragma unroll
        for (int kk = 0; kk < 2; ++kk) { const bf16x8 a = *(const LAS bf16x8*)(Dm + (16 * wave + fr) * 72 + 32 * kk + 8 * fq);
#pragma unroll
            for (int n = 0; n < 4; ++n) acc[n] = __builtin_amdgcn_mfma_f32_16x16x32_bf16(a, bfr[kk][n], acc[n], 0, 0, 0); }
#pragma unroll
        for (int n = 0; n < 4; ++n)
#pragma unroll
            for (int i = 0; i < 4; ++i) OUT[(16 * wave + 4 * fq + i) * 72 + 16 * n + fr] = (bf16)f2bf(acc[n][i] * psc[n]);
    }
    __syncthreads();
    {   const int p = tid >> 2, c = (tid & 3) * 16;
        const v4u o0 = *(const LAS v4u*)(OUT + p * 72 + c), o1 = *(const LAS v4u*)(OUT + p * 72 + c + 8);
        bf16* dst = MIX + (size_t)(row0 + p) * 1024 + 768 + 64 * G + c; *(v4u*)dst = o0; *(v4u*)(dst + 8) = o1; }
    __syncthreads();
}
__device__ __forceinline__ void prep_phase(const Args& A, Frame& F, int l, const bf16* Z, bf16* MIX, bf16* KB, bf16* VB) {
    prep_qkv(A, F, l, Z, MIX, KB, VB);
    const int NCH = (l + 1 < DEPTH) ? MT / 128 : NLAT / 128;
    unsigned* ctr = (unsigned*)(F.ws + WS_CTL) + 64 * (8 + l);
    volatile LAS unsigned* tk = (volatile LAS unsigned*)(F.lds + MISC_OFF) + 16;
    for (;;) {
        relaunder(F);
        if (F.tid == 0) tk[0] = atomicAdd(ctr, 1u);
        __syncthreads();
        const unsigned it = tk[0];
        __syncthreads();
        if (it >= (unsigned)(NCH * 8)) break;
        const int ord = (int)(it / NCH), ci = (int)(it % NCH);
        const int k = ord == 0 ? 7 : ord == 1 ? 6 : ord < 6 ? ord - 2 : ord == 6 ? 5 : 4;
        if (k < 4) sgu_item(A, F, l, ci, k, Z, MIX, (const float*)(F.ws + WS_RSSV) + (size_t)l * MT);
        else if (k == 4) pool_item<0>(A, F, l, ci, Z, MIX); else if (k == 5) pool_item<1>(A, F, l, ci, Z, MIX); else if (k == 6) pool_item<2>(A, F, l, ci, Z, MIX); else pool_item<3>(A, F, l, ci, Z, MIX);
    }
    bias_phase(F, (const float*)(F.ws + WS_MOD), l);
}

__device__ __forceinline__ void attention_phase(Frame& F, int l, char* lds, bf16* MIX, const bf16* KB, const bf16* VB) {
    const int nunits = (l == 0) ? 576 : 512;
    for (int i = 0;; ++i) {
        const int u = F.vcu + i * F.G; if (u >= nunits) break;
        const attn_body::bf16 *q, *k, *v; int NT;
        if (u < 512) { const int b = (u & 255) >> 5, r = (u & 31) + 32 * (u >> 8), h = r >> 3, qb = r & 7;
            q = (const attn_body::bf16*)MIX + ((size_t)b * SEQ + qb * 256) * 1024 + h * 64; k = (const attn_body::bf16*)KB + (size_t)b * NKEY * KVW + (h >> 2) * 64; v = (const attn_body::bf16*)VB + (size_t)b * NKEY * KVW + (h >> 2) * 64; NT = NKEY / 64; }
        else { const int c = u - 512, b = c >> 3, h = c & 7;
            q = (const attn_body::bf16*)MIX + ((size_t)NLAT + b * CTXL) * 1024 + h * 64; k = (const attn_body::bf16*)KB + (size_t)b * NKEY * KVW + (h >> 2) * 64; v = (const attn_body::bf16*)VB + (size_t)b * NKEY * KVW + (h >> 2) * 64; NT = CTXL / 64; }
        attn_body::attn_unit<8>(q, k, v, (attn_body::bf16*)q, NT, lds);
    }
}

__global__ void __launch_bounds__(NTHR, 2) fwd_megakernel(const Args args) {
    const Args& A = args;
    extern __shared__ __attribute__((aligned(16))) unsigned char lds[];
    Frame F;
    F.lds = (LAS unsigned char*)lds;
    relaunder(F);
    for (int u = threadIdx.x; u < (LDS_BYTES - LDSCTL_OFF) / 4; u += NTHR) ((LAS unsigned*)((LAS unsigned char*)lds + LDSCTL_OFF))[u] = 0u;
    __syncthreads();
    (void)xcd_barrier_post((unsigned*)(args.ws + WS_CTL) + CW_BAR, (volatile LAS unsigned*)((LAS unsigned char*)lds + MISC_OFF) + 8);
#define GRID_BAR() do { __attribute__((address_space(1))) unsigned* bp_ = (__attribute__((address_space(1))) unsigned*)((unsigned*)(args.ws + WS_CTL) + CW_BAR); asm volatile("" : "+s"(bp_)); XcdBarrier b_; b_.bar = (unsigned*)bp_; b_.x = xb_xcc_id(); b_.st = (volatile LAS unsigned*)((LAS unsigned char*)lds + MISC_OFF) + 8; xcd_barrier(b_); } while (0)
    F.G = gridDim.x; { const int bx = blockIdx.x; F.vcu = (F.G % 8 == 0) ? (bx % 8) * (F.G / 8) + bx / 8 : bx; }
    F.out = args.out; F.ws = args.ws;
#define GASP __attribute__((address_space(1)))
#define WSL() ({ GASP unsigned char* w_ = (GASP unsigned char*)args.ws; asm volatile("" : "+s"(w_)); (unsigned char*)w_; })
#define P_H ((bf16*)(WSL() + WS_H))
#define P_Z ((bf16*)(WSL() + WS_Z))
#define P_MIX ((bf16*)(WSL() + WS_MIX))
#define P_KB ((bf16*)(WSL() + WS_KB))
#define P_VB ((bf16*)(WSL() + WS_VB))
#define P_ACT ((bf16*)(WSL() + WS_ACT))
#define P_CTXRES ((float*)(WSL() + WS_CTXRES))
#define P_XRES ({ GASP float* o_ = (GASP float*)args.out; asm volatile("" : "+s"(o_)); (float*)o_; })
#define P_MOD ((const float*)(WSL() + WS_MOD))
#define P_RSS ((float*)(WSL() + WS_RSS))
#define P_BIASIN ((const float*)(WSL() + WS_BIAS))
#define P_BIASGU ((const float*)(WSL() + WS_BIAS) + (size_t)DEPTH * 9 * INW)
#define P_SLABS ((float*)(WSL() + WS_SLAB))
#define P_XH ((unsigned short*)(WSL() + WS_XH))

    p0_prologue(args, F);
    GRID_BAR();
    norm_phase(F, A.in[0], A.in[2], MT, A.in[6], P_MOD, 1024, P_H, P_RSS + 3 * MT);
    bias_phase(F, P_MOD, -1);
    GRID_BAR();
    {
        const int Mrows = (0 == 0) ? MT : NLAT;
        {   pg8::Gemm g{P_H, (const bf16*)(WSL() + WS_WIN) + (size_t)0 * INW * 1024, MT, INW, 1024}; pg8::StaticOrder S; S.init(MT, INW, F.G, (int)blockIdx.x);
            pg8::EpiStoreBf16 E{P_Z, INW, P_RSS + (0 == 0 ? 3 : 1) * MT, P_BIASIN + (size_t)0 * 9 * INW, INW, F.lds, (float*)(WSL() + WS_RSSV) + (size_t)0 * MT};
            pg8::gemm_phase<pg8::EpiStoreBf16, pg8::StaticOrder, true, true>(F.lds, g, S, E); }
        tail_transposes(args, F, 1, (MT / 256) * (INW / 256));
        GRID_BAR();
        prep_phase(args, F, 0, P_Z, P_MIX, P_KB, P_VB);
        GRID_BAR();
        attention_phase(F, 0, (char*)lds, P_MIX, P_KB, P_VB);
        GRID_BAR();
        {   pg8::Gemm g{P_MIX, (const bf16*)(WSL() + WS_WOUT) + (size_t)0 * 1024 * 1024, Mrows, 1024, 1024};
            pg8::EpiResid<true> E{A.in[0], P_XH, (P_MOD + (size_t)0 * 9 * MODW) + 2048, A.in[7] + 0 * DMODEL, (P_MOD + (size_t)0 * 9 * MODW) + 4096, P_H, P_RSS + (0 == 0 ? 0 : 2) * MT};
            if (0 == 0) { pg8::SliceOrder S2; S2.init(1024, KSPLIT, F.G, (int)blockIdx.x); pg8::EpiSlab E2{P_SLABS}; pg8::gemm_phase<pg8::EpiSlab, pg8::SliceOrder, true, true>(F.lds, g, S2, E2); }
            pg8::StaticOrder S; S.init(NLAT, 1024, F.G, (int)blockIdx.x); pg8::gemm_phase<pg8::EpiResid<true>, pg8::StaticOrder, false, true>(F.lds, g, S, E); }
        GRID_BAR();
        if (0 == 0) { ctx_combine_phase(F, P_SLABS, ((0 == 0) ? A.in[2] : (const float*)P_CTXRES), P_CTXRES, (P_MOD + (size_t)0 * 9 * MODW) + 2048, A.in[7] + 0 * DMODEL, (P_MOD + (size_t)0 * 9 * MODW) + 4096, P_H, P_RSS + 0 * MT); GRID_BAR(); }
        {   pg8::Gemm g{P_H, (const bf16*)(WSL() + WS_WGU) + (size_t)0 * 2 * FF * 1024, Mrows, 2 * FF, 1024}; pg8::CtxFirstOrder S; S.init(2 * FF, F.G, (int)blockIdx.x);
            unsigned* ctx_done = (unsigned*)(WSL() + WS_CTL) + 64 * 11;
            pg8::EpiSwiGLU E{P_ACT, FF, P_RSS + (0 == 0 ? 0 : 2) * MT, P_BIASGU + (size_t)0 * 9 * 2 * FF, 2 * FF, F.lds, ctx_done};
            pg8::gemm_phase<pg8::EpiSwiGLU, pg8::CtxFirstOrder, true, true>(F.lds, g, S, E);
            {   const int nwg = (MT / 256) * (2 * FF / 256), G = F.G, rounds = (nwg + G - 1) / G; int first_idle = nwg - G * (rounds - 1); if (first_idle >= G) first_idle = 0;
                if ((int)blockIdx.x >= first_idle) {
                    if (threadIdx.x == 0) { unsigned sp = 0;
                        while (__hip_atomic_load(ctx_done, __ATOMIC_RELAXED, __HIP_MEMORY_SCOPE_AGENT) < 8u * (2 * FF / 256)) { __builtin_amdgcn_s_sleep(2); if (++sp > (1u << 20)) break; }
                        __builtin_amdgcn_fence(__ATOMIC_ACQUIRE, "agent"); asm volatile("s_waitcnt vmcnt(0)" ::: "memory"); }
                    __syncthreads();
                    pg8::Gemm g2{P_ACT, (const bf16*)(WSL() + WS_WDN) + (size_t)0 * 1024 * FF, Mrows, 1024, FF};
                    pg8::SliceOrder S2; S2.init(FF, KSPLIT, G - first_idle, (int)blockIdx.x - first_idle); pg8::EpiSlab E2{P_SLABS};
                    pg8::gemm_phase<pg8::EpiSlab, pg8::SliceOrder, true, true>(F.lds, g2, S2, E2); } } }
        GRID_BAR();
        ctx_combine_phase(F, P_SLABS, P_CTXRES, P_CTXRES, (P_MOD + (size_t)0 * 9 * MODW) + 5120, A.in[6] + 1 * DMODEL, P_MOD + (size_t)1 * 9 * MODW + 1024, P_H, P_RSS + 1 * MT);
        {   pg8::Gemm g{P_ACT, (const bf16*)(WSL() + WS_WDN) + (size_t)0 * 1024 * FF, Mrows, 1024, FF}; pg8::StaticOrder S; S.init(NLAT, 1024, F.G, (int)blockIdx.x);
            const int nl = (0 + 1 < DEPTH) ? 0 + 1 : 0;
            pg8::EpiResid<false> E{P_XH, P_XH, (P_MOD + (size_t)0 * 9 * MODW) + 5120, A.in[6] + nl * DMODEL, P_MOD + (size_t)nl * 9 * MODW + 1024, P_H, P_RSS + 1 * MT};
            pg8::gemm_phase<pg8::EpiResid<false>, pg8::StaticOrder, false, true>(F.lds, g, S, E); }
        GRID_BAR();
    }
    {
        const int Mrows = (1 == 0) ? MT : NLAT;
        {   pg8::Gemm g{P_H, (const bf16*)(WSL() + WS_WIN) + (size_t)1 * INW * 1024, MT, INW, 1024}; pg8::StaticOrder S; S.init(MT, INW, F.G, (int)blockIdx.x);
            pg8::EpiStoreBf16 E{P_Z, INW, P_RSS + (1 == 0 ? 3 : 1) * MT, P_BIASIN + (size_t)1 * 9 * INW, INW, F.lds, (float*)(WSL() + WS_RSSV) + (size_t)1 * MT};
            pg8::gemm_phase<pg8::EpiStoreBf16, pg8::StaticOrder, true, true>(F.lds, g, S, E); }
        tail_transposes(args, F, 2, (MT / 256) * (INW / 256));
        GRID_BAR();
        prep_phase(args, F, 1, P_Z, P_MIX, P_KB, P_VB);
        GRID_BAR();
        attention_phase(F, 1, (char*)lds, P_MIX, P_KB, P_VB);
        GRID_BAR();
        {   pg8::Gemm g{P_MIX, (const bf16*)(WSL() + WS_WOUT) + (size_t)1 * 1024 * 1024, Mrows, 1024, 1024};
            pg8::EpiResid<false> E{P_XH, P_XH, (P_MOD + (size_t)1 * 9 * MODW) + 2048, A.in[7] + 1 * DMODEL, (P_MOD + (size_t)1 * 9 * MODW) + 4096, P_H, P_RSS + (1 == 0 ? 0 : 2) * MT};
            pg8::StaticOrder S; S.init(NLAT, 1024, F.G, (int)blockIdx.x); pg8::gemm_phase<pg8::EpiResid<false>, pg8::StaticOrder, false, true>(F.lds, g, S, E);
            if (1 == 0) { pg8::SliceOrder S2; S2.init(1024, KSPLIT, F.G, (int)blockIdx.x); pg8::EpiSlab E2{P_SLABS}; pg8::gemm_phase<pg8::EpiSlab, pg8::SliceOrder, true, true>(F.lds, g, S2, E2); } }
        GRID_BAR();
        if (1 == 0) { ctx_combine_phase(F, P_SLABS, ((1 == 0) ? A.in[2] : (const float*)P_CTXRES), P_CTXRES, (P_MOD + (size_t)1 * 9 * MODW) + 2048, A.in[7] + 1 * DMODEL, (P_MOD + (size_t)1 * 9 * MODW) + 4096, P_H, P_RSS + 0 * MT); GRID_BAR(); }
        {   pg8::Gemm g{P_H, (const bf16*)(WSL() + WS_WGU) + (size_t)1 * 2 * FF * 1024, Mrows, 2 * FF, 1024}; pg8::StaticOrder S; S.init(Mrows, 2 * FF, F.G, (int)blockIdx.x);
            pg8::EpiSwiGLU E{P_ACT, FF, P_RSS + (1 == 0 ? 0 : 2) * MT, P_BIASGU + (size_t)1 * 9 * 2 * FF, 2 * FF, F.lds, nullptr};
            pg8::gemm_phase<pg8::EpiSwiGLU, pg8::StaticOrder, true, true>(F.lds, g, S, E); }
        GRID_BAR();
        {   pg8::Gemm g{P_ACT, (const bf16*)(WSL() + WS_WDN) + (size_t)1 * 1024 * FF, Mrows, 1024, FF}; pg8::StaticOrder S; S.init(NLAT, 1024, F.G, (int)blockIdx.x);
            const int nl = (1 + 1 < DEPTH) ? 1 + 1 : 1;
            if (F.G == 256) {
                pg8::EpiResidFinal E{P_XH, P_XRES, (P_MOD + (size_t)1 * 9 * MODW) + 5120, A.in[20], P_RSS + 4 * MT, (unsigned*)(WSL() + WS_CTL) + CW_PANEL, (LAS unsigned*)(F.lds + MISC_OFF) + 20};
                pg8::gemm_phase<pg8::EpiResidFinal, pg8::StaticOrder, true, true>(F.lds, g, S, E);
            } else {
            pg8::EpiResid<false> E{P_XH, P_XH, (P_MOD + (size_t)1 * 9 * MODW) + 5120, A.in[6] + nl * DMODEL, P_MOD + (size_t)nl * 9 * MODW + 1024, P_H, P_RSS + 1 * MT};
            pg8::gemm_phase<pg8::EpiResid<false>, pg8::StaticOrder, false, true>(F.lds, g, S, E); }
            if (1 == 0) { pg8::SliceOrder S2; S2.init(FF, KSPLIT, F.G, (int)blockIdx.x); pg8::EpiSlab E2{P_SLABS}; pg8::gemm_phase<pg8::EpiSlab, pg8::SliceOrder, true, true>(F.lds, g, S2, E2); } }
        if (F.G != 256) GRID_BAR();
        if (1 == 0) { ctx_combine_phase(F, P_SLABS, P_CTXRES, P_CTXRES, (P_MOD + (size_t)1 * 9 * MODW) + 5120, A.in[6] + 1 * DMODEL, P_MOD + (size_t)1 * 9 * MODW + 1024, P_H, P_RSS + 1 * MT); GRID_BAR(); }
    }
    if (F.G != 256) final_norm_phase(F, P_XH, P_XRES, A.in[20]);
}

extern "C" void kernel_launch(void* const* d_in, const int* in_sizes, int n_in, void* d_out, int out_size, void* d_ws, size_t ws_size, hipStream_t stream) {
    static int grid = 0;
    if (grid == 0) {
        if (n_in != 21 || out_size != NLAT * DMODEL || ws_size < 256 * MiB) { fprintf(stderr, "kernel_launch: unexpected shapes (n_in %d out %d ws %zu)\n", n_in, out_size, ws_size); grid = -1; return; }
        int dev = 0, cus = 0, per_cu = 0;
        hipGetDevice(&dev); hipDeviceGetAttribute(&cus, hipDeviceAttributeMultiprocessorCount, dev);
        if (hipFuncSetAttribute((const void*)fwd_megakernel, hipFuncAttributeMaxDynamicSharedMemorySize, LDS_BYTES) != hipSuccess) { fprintf(stderr, "kernel_launch: hipFuncSetAttribute failed\n"); grid = -1; return; }
        if (hipOccupancyMaxActiveBlocksPerMultiprocessor(&per_cu, (const void*)fwd_megakernel, NTHR, LDS_BYTES) != hipSuccess || per_cu < 1) { fprintf(stderr, "kernel_launch: occupancy query says %d blocks per CU\n", per_cu); (void)hipGetLastError(); grid = -1; return; }
        grid = cus * 1;
        fprintf(stderr, "kernel_launch: grid %d (cus %d, per_cu %d)\n", grid, cus, per_cu);
    }
    if (grid < 0) return;
    (void)hipMemsetAsync((char*)d_ws + WS_CTL, 0, CTL_ZERO_BYTES, stream);
    Args a{};
    for (int i = 0; i < 21; ++i) a.in[i] = (const float*)d_in[i];
    a.out = (float*)d_out; a.ws = (unsigned char*)d_ws; a.pad = 0ull;
    void* kargs[] = {&a};
    hipError_t e = hipLaunchCooperativeKernel((const void*)fwd_megakernel, dim3(grid), dim3(NTHR), kargs, LDS_BYTES, stream);
    if (e != hipSuccess) fprintf(stderr, "kernel_launch: cooperative launch failed: %s (grid %d)\n", hipGetErrorString(e), grid);
}
```
